# Optimizing an MI355X kernel written in HIP

```python
import math
import jax, jax.numpy as jnp
from jax import lax
import numpy as np

D_MODEL = 1024
BATCH = 16
SEQ = 2048
DEPTH = 1

MIX_WIDTH = D_MODEL
ATT_WIDTH = MIX_WIDTH // 2
SGU_WIDTH = MIX_WIDTH - ATT_WIDTH
DIFF_HEADS = 4
DIFF_HEAD_DIM = ATT_WIDTH // DIFF_HEADS // 2
DIFF_VALUE_DIM = 2 * DIFF_HEAD_DIM
ROPE_DIM = DIFF_HEAD_DIM // 4
ROPE_THETA = 500000.0
QBLOCK = 128
SGU_GROUPS = 4
SGU_GROUP_WIDTH = SGU_WIDTH // SGU_GROUPS
CHUNK = 128
Q_COLS = DIFF_HEADS * 2 * DIFF_HEAD_DIM
K_COLS = DIFF_HEADS * 2 * DIFF_HEAD_DIM
V_COLS = DIFF_HEADS * DIFF_VALUE_DIM
IN_COLS = Q_COLS + K_COLS + V_COLS + 2 * SGU_WIDTH
N_GROUPS = 4
EXPERTS_PER_GROUP = 8
N_EXPERTS = N_GROUPS * EXPERTS_PER_GROUP
TOP_K_IN_GROUP = 2
D_FF_EXPERT = D_MODEL // 2
RMS_EPS = 1e-6
NEG_INF = -1e30

kernel_name = "hymba_diffattn_sgu_hmoe_layer"


def rms_norm(x, g):
    xf = x.astype(jnp.float32)
    y = xf * lax.rsqrt(jnp.mean(xf * xf, axis=-1, keepdims=True) + RMS_EPS)
    return (y * g.astype(jnp.float32)).astype(x.dtype)


def layer_norm(x, g, b):
    xf = x.astype(jnp.float32)
    mu = jnp.mean(xf, axis=-1, keepdims=True)
    xc = xf - mu
    y = xc * lax.rsqrt(jnp.mean(xc * xc, axis=-1, keepdims=True) + RMS_EPS)
    return (y * g.astype(jnp.float32) + b.astype(jnp.float32)).astype(x.dtype)


def rope_tables(positions):
    inv_freq = ROPE_THETA ** (-jnp.arange(0, ROPE_DIM, 2, dtype=jnp.float32) / ROPE_DIM)
    ang = positions.astype(jnp.float32)[..., None] * inv_freq
    return jnp.cos(ang), jnp.sin(ang)


def apply_partial_rope(x, cos, sin):
    half = ROPE_DIM // 2
    c = cos[:, :, None, None, :]
    s = sin[:, :, None, None, :]
    x1 = x[..., :half].astype(jnp.float32)
    x2 = x[..., half:ROPE_DIM].astype(jnp.float32)
    r1 = (x1 * c - x2 * s).astype(x.dtype)
    r2 = (x1 * s + x2 * c).astype(x.dtype)
    return jnp.concatenate([r1, r2, x[..., ROPE_DIM:]], axis=-1)


def diff_attention(q, k, v, lam):
    B, S, H, _, d = q.shape
    nb = S // QBLOCK
    kt = k.transpose(0, 2, 3, 1, 4)
    vt = v.transpose(0, 2, 1, 3)
    qb = q.transpose(0, 2, 3, 1, 4).reshape(B, H, 2, nb, QBLOCK, d).transpose(3, 0, 1, 2, 4, 5)
    key_pos = jnp.arange(S)

    def block(args):
        q_blk, i = args
        s = jnp.einsum('bhmqd,bhmkd->bhmqk', q_blk, kt, preferred_element_type=jnp.float32)
        q_pos = i * QBLOCK + jnp.arange(QBLOCK)
        mask = key_pos[None, :] <= q_pos[:, None]
        s = jnp.where(mask, s, NEG_INF)
        p = jax.nn.softmax(s, axis=-1)
        a = p[:, :, 0] - lam * p[:, :, 1]
        return jnp.einsum('bhqk,bhkv->bhqv', a.astype(vt.dtype), vt)

    out = lax.map(block, (qb, jnp.arange(nb)))
    return out.transpose(1, 0, 3, 2, 4).reshape(B, S, H, DIFF_VALUE_DIM)


def spatial_gating(u, v, ln_g, ln_b, w_s, b_s):
    B, S, _ = v.shape
    nc = S // CHUNK
    vn = layer_norm(v, ln_g, ln_b)
    vc = vn.reshape(B, nc, CHUNK, SGU_GROUPS, SGU_GROUP_WIDTH)
    w = w_s * jnp.tril(jnp.ones((CHUNK, CHUNK), dtype=w_s.dtype))
    s = jnp.einsum('gts,bcsgd->bctgd', w, vc) + b_s.T[None, None, :, :, None]
    return u * s.reshape(B, S, SGU_WIDTH)


def hier_moe(h, wg, bg, we, be, w_gate, w_up, w_down):
    B, S, D = h.shape
    T = B * S
    xt = h.reshape(T, D)
    g_logits = (xt @ wg).astype(jnp.float32) + bg.astype(jnp.float32)
    g_probs = jax.nn.softmax(g_logits, axis=-1)
    p_grp, grp = lax.top_k(g_probs, 1)
    e_logits = ((xt @ we).astype(jnp.float32) + be.astype(jnp.float32)).reshape(T, N_GROUPS, EXPERTS_PER_GROUP)
    e_logits = jnp.take_along_axis(e_logits, grp[:, :, None], axis=1)[:, 0]
    top_logit, top_e = lax.top_k(e_logits, TOP_K_IN_GROUP)
    gates = p_grp * jax.nn.softmax(top_logit, axis=-1)
    flat_id = (grp * EXPERTS_PER_GROUP + top_e).reshape(-1)
    order = jnp.argsort(flat_id)
    tok = order // TOP_K_IN_GROUP
    xs = xt[tok]
    sizes = jnp.bincount(flat_id, length=N_EXPERTS).astype(jnp.int32)
    hg = lax.ragged_dot(xs, w_gate, sizes)
    hu = lax.ragged_dot(xs, w_up, sizes)
    ys = lax.ragged_dot(jax.nn.silu(hg) * hu, w_down, sizes)
    ys = ys * gates.reshape(-1)[order][:, None].astype(ys.dtype)
    out = jnp.zeros((T, D), dtype=ys.dtype).at[tok].add(ys)
    return out.reshape(B, S, D)


def setup_inputs(seed: int = 0) -> dict:
    key = jax.random.key(seed)
    ks = jax.random.split(key, 24)
    f32 = jnp.float32
    L = DEPTH

    def nrm(k, shape, scale):
        return jax.random.normal(k, shape, f32) * scale

    x = jax.random.normal(ks[0], (BATCH, SEQ, D_MODEL), f32)
    offset = jax.random.randint(ks[1], (BATCH, 1), 0, 4096, dtype=jnp.int32)
    positions = (offset + jnp.arange(SEQ, dtype=jnp.int32)[None, :]).astype(jnp.int32)
    return {
        "x": x,
        "positions": positions,
        "norm_mix_g": 1.0 + nrm(ks[2], (L, D_MODEL), 0.02),
        "w_in": nrm(ks[3], (L, D_MODEL, IN_COLS), D_MODEL ** -0.5),
        "q_norm_g": 1.0 + nrm(ks[4], (L, DIFF_HEAD_DIM), 0.02),
        "k_norm_g": 1.0 + nrm(ks[5], (L, DIFF_HEAD_DIM), 0.02),
        "lambda_q1": nrm(ks[6], (L, DIFF_HEAD_DIM), 0.1),
        "lambda_k1": nrm(ks[7], (L, DIFF_HEAD_DIM), 0.1),
        "lambda_q2": nrm(ks[8], (L, DIFF_HEAD_DIM), 0.1),
        "lambda_k2": nrm(ks[9], (L, DIFF_HEAD_DIM), 0.1),
        "diff_out_norm_g": 1.0 + nrm(ks[10], (L, DIFF_VALUE_DIM), 0.02),
        "sgu_ln_g": 1.0 + nrm(ks[11], (L, SGU_WIDTH), 0.02),
        "sgu_ln_b": nrm(ks[12], (L, SGU_WIDTH), 0.02),
        "sgu_w": nrm(ks[13], (L, SGU_GROUPS, CHUNK, CHUNK), 0.5 * CHUNK ** -0.5),
        "sgu_b": 1.0 + nrm(ks[14], (L, SGU_GROUPS, CHUNK), 0.01),
        "sgu_out_norm_g": 1.0 + nrm(ks[15], (L, SGU_GROUPS, SGU_GROUP_WIDTH), 0.02),
        "w_out": nrm(ks[16], (L, MIX_WIDTH, D_MODEL), MIX_WIDTH ** -0.5),
        "norm_ffn_g": 1.0 + nrm(ks[17], (L, D_MODEL), 0.02),
        "router_group_w": nrm(ks[18], (L, D_MODEL, N_GROUPS), D_MODEL ** -0.5),
        "router_group_b": nrm(ks[19], (L, N_GROUPS), 0.01),
        "router_expert_w": nrm(ks[20], (L, D_MODEL, N_EXPERTS), D_MODEL ** -0.5),
        "router_expert_b": nrm(ks[21], (L, N_EXPERTS), 0.01),
        "expert_w_gate": nrm(ks[22], (L, N_EXPERTS, D_MODEL, D_FF_EXPERT), D_MODEL ** -0.5),
        "expert_w_up": nrm(jax.random.fold_in(ks[22], 1), (L, N_EXPERTS, D_MODEL, D_FF_EXPERT), D_MODEL ** -0.5),
        "expert_w_down": nrm(ks[23], (L, N_EXPERTS, D_FF_EXPERT, D_MODEL), D_FF_EXPERT ** -0.5),
    }


def reference(x, positions, norm_mix_g, w_in, q_norm_g, k_norm_g, lambda_q1, lambda_k1,
              lambda_q2, lambda_k2, diff_out_norm_g, sgu_ln_g, sgu_ln_b, sgu_w, sgu_b,
              sgu_out_norm_g, w_out, norm_ffn_g, router_group_w, router_group_b,
              router_expert_w, router_expert_b, expert_w_gate, expert_w_up, expert_w_down):
    B, S, _ = x.shape
    cos, sin = rope_tables(positions)
    scale = DIFF_HEAD_DIM ** -0.5
    h = x
    for l in range(DEPTH):
        lambda_init = 0.8 - 0.6 * math.exp(-0.3 * l)
        hn = rms_norm(h, norm_mix_g[l])
        proj = hn @ w_in[l]
        q, k, v, su, sv = jnp.split(
            proj, [Q_COLS, Q_COLS + K_COLS, Q_COLS + K_COLS + V_COLS, Q_COLS + K_COLS + V_COLS + SGU_WIDTH], axis=-1)
        q = q.reshape(B, S, DIFF_HEADS, 2, DIFF_HEAD_DIM)
        k = k.reshape(B, S, DIFF_HEADS, 2, DIFF_HEAD_DIM)
        v = v.reshape(B, S, DIFF_HEADS, DIFF_VALUE_DIM)
        q = apply_partial_rope(rms_norm(q, q_norm_g[l]), cos, sin) * scale
        k = apply_partial_rope(rms_norm(k, k_norm_g[l]), cos, sin)
        lam = (jnp.exp(jnp.sum(lambda_q1[l].astype(jnp.float32) * lambda_k1[l].astype(jnp.float32)))
               - jnp.exp(jnp.sum(lambda_q2[l].astype(jnp.float32) * lambda_k2[l].astype(jnp.float32)))
               + lambda_init)
        att = diff_attention(q, k, v, lam)
        att = rms_norm(att, diff_out_norm_g[l]) * (1.0 - lambda_init)
        att = att.reshape(B, S, ATT_WIDTH)
        su = jax.nn.gelu(su, approximate=False)
        sv = jax.nn.gelu(sv, approximate=False)
        sg = spatial_gating(su, sv, sgu_ln_g[l], sgu_ln_b[l], sgu_w[l], sgu_b[l])
        sg = rms_norm(sg.reshape(B, S, SGU_GROUPS, SGU_GROUP_WIDTH), sgu_out_norm_g[l]).reshape(B, S, SGU_WIDTH)
        mix = jnp.concatenate([att, sg], axis=-1)
        h = h + mix @ w_out[l]
        hn = rms_norm(h, norm_ffn_g[l])
        h = h + hier_moe(hn, router_group_w[l], router_group_b[l], router_expert_w[l], router_expert_b[l],
                         expert_w_gate[l], expert_w_up[l], expert_w_down[l])
    return h
```

```cpp
#define MK_N_LAUNCHES 8
#include <hip/hip_runtime.h>
#include <hip/hip_bf16.h>
#include <cstdio>
#include <cstdint>
#include <cmath>
namespace pg8 {
#define PG8_LAS __attribute__((address_space(3)))
typedef unsigned short bf16_t;
typedef short bf16x8 __attribute__((ext_vector_type(8)));
typedef float f32x4 __attribute__((ext_vector_type(4)));
typedef unsigned u32x4 __attribute__((ext_vector_type(4)));
typedef unsigned u32x2 __attribute__((ext_vector_type(2)));
constexpr int BM = 256, BK = 64, HALF = 128, HTB = HALF * BK * 2  , STAGE_BYTES = 8 * HTB, NXCD = 8, WGM = 8;

__host__ __device__ __forceinline__ int lds_byte(int r, int c) { const int st = (r >> 4) * 2 + (c >> 5), rr = r & 15, cc = c & 31, ob = rr * 64 + cc * 2; return st * 1024 + (ob ^ (((ob >> 9) & 1) << 5)); }
__host__ __device__ __forceinline__ void stage_rc(int b, int& R, int& C) { const int st = b / 1024, sb = b % 1024, swz = sb ^ (((sb >> 9) & 1) << 5); R = (st >> 1) * 16 + swz / 64; C = (st & 1) * 32 + (swz % 64) / 2; }
__host__ __device__ __forceinline__ int perm32(int rho) { const int n = rho >> 4, i = rho & 15; return 8 * (i >> 2) + 4 * n + (i & 3); }

struct Unit { int arow, brow, pm, pn, e, nvalid; const int* lst; };
struct Gemm { const bf16_t* A; const bf16_t* Bt; int K; };

__device__ __forceinline__ unsigned cvt_pk_bf16(float lo, float hi) { unsigned r; asm volatile("v_cvt_pk_bf16_f32 %0, %1, %2" : "=v"(r) : "v"(lo), "v"(hi)); return r; }
__device__ __forceinline__ float bf_lo(unsigned w) { return __uint_as_float(w << 16); }
__device__ __forceinline__ float bf_hi(unsigned w) { return __uint_as_float(w & 0xffff0000u); }
typedef float f32x2 __attribute__((ext_vector_type(2)));
__device__ __forceinline__ f32x2 gelu_pk(f32x2 v) {
    const f32x2 av = __builtin_elementwise_abs(v), d = av * 0.2316418882f + 1.0f;
    f32x2 t; t.x = __builtin_amdgcn_rcpf(d.x); t.y = __builtin_amdgcn_rcpf(d.y);
    f32x2 q = t * 0.5307027145f + (-0.7265760135f); q = q * t + 0.7107068705f; q = q * t + (-0.142248368f); q = q * t + 0.127414796f; q = q * t;
    const f32x2 s = (v * v) * (-0.72134752044f);
    f32x2 e; e.x = __builtin_amdgcn_exp2f(s.x); e.y = __builtin_amdgcn_exp2f(s.y);
    const f32x2 m = v * (q * e), r = v - m;
    f32x2 o; o.x = v.x < 0.f ? m.x : r.x; o.y = v.y < 0.f ? m.y : r.y; return o;
}

struct StaticOrder {
    int nM, nN, nwg, G, c;
    __device__ void init(int M, int N, int G_, int c_) { nM = M / BM; nN = N / BM; nwg = nM * nN; G = G_; c = c_; }
    __device__ bool next(int i, Unit& u) const {
        const long L = (long)i * G + c; if (L >= nwg) return false;
        int wgid = (int)L; { const int q = nwg / NXCD, r = nwg % NXCD, xcd = wgid % NXCD, off = wgid / NXCD; wgid = (xcd < r ? xcd * (q + 1) : r * (q + 1) + (xcd - r) * q) + off; }
        const int nig = WGM * nN, gid = wgid / nig, fm = gid * WGM, gsz = (nM - fm) < WGM ? (nM - fm) : WGM;
        u.pm = fm + ((wgid % nig) % gsz); u.pn = (wgid % nig) / gsz; u.arow = u.pm * BM; u.brow = u.pn * BM; u.e = 0; u.nvalid = BM; u.lst = nullptr; return true;
    }
};

template <class Epi, class Sched, bool GATHER>
__device__ __forceinline__ void gemm_phase(PG8_LAS unsigned char* lds, const Gemm g, const Sched& S, const Epi& E, const int wid  ) {
    int lane = (int)__builtin_amdgcn_mbcnt_hi(~0u, __builtin_amdgcn_mbcnt_lo(~0u, 0u)); asm volatile("" : "+v"(lane));
    const int tid = wid * 64 + lane, wr = wid >> 2, wc = wid & 3, fr = lane & 15, fq = lane >> 4;
    const int K = g.K, nt = K / BK;
    unsigned voffA[2], voffB[2]; int RA[2], CA[2];
#pragma unroll
    for (int i = 0; i < 2; ++i) { int R, C; stage_rc(tid * 16 + i * 8192, R, C); const int Rb = (R & ~31) + perm32(R & 31);
        voffA[i] = (unsigned)(R * K + C) * 2u; voffB[i] = (unsigned)(Rb * K + C) * 2u; RA[i] = R; CA[i] = C * 2; }
    const size_t kstep = (size_t)(BK * 2);
    const size_t hstep = (size_t)HALF * K * 2;
    const unsigned ldsw = (unsigned)wid * 1024u;
    const int aoff = lds_byte(wr * 64 + fr, fq * 8), boff = lds_byte(wc * 32 + fr, fq * 8);
#define PG8_SA(b, h) (((b) * 2 + (h)) * HTB)
#define PG8_SB(b, h) ((4 + (b) * 2 + (h)) * HTB)
#define PG8_STAGE(bufoff, gbase, voff) do { _Pragma("unroll") for (int _i = 0; _i < 2; ++_i) \
        __builtin_amdgcn_global_load_lds((const unsigned*)((const char*)(gbase) + (voff)[_i]), (PG8_LAS unsigned*)(lds + (bufoff) + ldsw + _i * 8192), 16, 0, 0); } while (0)
#define PG8_STAGE_A(bufoff, kofs, h, nx) do { if constexpr (GATHER) { unsigned _o[2]; _o[0] = (nx) ? gN[h][0] : gC[h][0]; _o[1] = (nx) ? gN[h][1] : gC[h][1]; PG8_STAGE(bufoff, (const char*)g.A + (kofs), _o); } \
        else { PG8_STAGE(bufoff, ((nx) ? nA : cA) + (size_t)(h) * hstep + (kofs), voffA); } } while (0)
#define PG8_LDA(dst, b, h) do { _Pragma("unroll") for (int m = 0; m < 4; ++m) _Pragma("unroll") for (int k = 0; k < 2; ++k) dst[m][k] = *(const PG8_LAS bf16x8*)(lds + PG8_SA(b, h) + aoff + m * 2048 + k * 1024); } while (0)
#define PG8_LDB(dst, b, h) do { _Pragma("unroll") for (int n = 0; n < 2; ++n) _Pragma("unroll") for (int k = 0; k < 2; ++k) dst[n][k] = *(const PG8_LAS bf16x8*)(lds + PG8_SB(b, h) + boff + n * 2048 + k * 1024); } while (0)
#define PG8_MMA(ai, bj, At, Bt) do { __builtin_amdgcn_s_setprio(1); _Pragma("unroll") for (int m = 0; m < 4; ++m) _Pragma("unroll") for (int n = 0; n < 2; ++n) _Pragma("unroll") for (int k = 0; k < 2; ++k) \
        acc[ai][bj][m][n] = __builtin_amdgcn_mfma_f32_16x16x32_bf16(Bt[n][k], At[m][k], acc[ai][bj][m][n], 0, 0, 0); __builtin_amdgcn_s_setprio(0); } while (0)
#define PG8_WAIT_V(n) asm volatile("s_waitcnt vmcnt(" #n ")" ::: "memory")
#define PG8_WAIT_L(n) asm volatile("s_waitcnt lgkmcnt(" #n ")" ::: "memory")
#define PG8_BAR __builtin_amdgcn_s_barrier()
#define PG8_SCHED __builtin_amdgcn_sched_barrier(0)
#define PG8_GOFF(G_, U) do { _Pragma("unroll") for (int _h = 0; _h < 2; ++_h) _Pragma("unroll") for (int _i = 0; _i < 2; ++_i) { int _ix = _h * HALF + RA[_i]; _ix = _ix < (U).nvalid ? _ix : (U).nvalid - 1; \
        const int _p = (U).lst[_ix]; G_[_h][_i] = (unsigned)(_p >> 1) * (unsigned)(K * 2) + (unsigned)CA[_i]; } } while (0)
    Unit cur, nxt; int ui = 0;
    if (!S.next(0, cur)) return;
    f32x4 acc[2][2][4][2];
#pragma unroll
    for (int a = 0; a < 2; ++a)
#pragma unroll
        for (int b = 0; b < 2; ++b)
#pragma unroll
            for (int m = 0; m < 4; ++m)
#pragma unroll
                for (int n = 0; n < 2; ++n) acc[a][b][m][n] = (f32x4){0.f, 0.f, 0.f, 0.f};
    bf16x8 At[4][2], B0[2][2], B1[2][2];
    unsigned gC[2][2] = {{0u, 0u}, {0u, 0u}}, gN[2][2] = {{0u, 0u}, {0u, 0u}};
    if constexpr (GATHER) { PG8_GOFF(gC, cur); }
    const char* cA = (const char*)g.A + (size_t)cur.arow * K * 2; const char* cB = (const char*)g.Bt + (size_t)cur.brow * K * 2;
    const char* nA = cA; const char* nB = cB;
    PG8_STAGE(PG8_SB(0, 0), cB, voffB); PG8_STAGE(PG8_SB(0, 1), cB + hstep, voffB); PG8_STAGE_A(PG8_SA(0, 0), 0, 0, false); PG8_STAGE_A(PG8_SA(0, 1), 0, 1, false);
    if (wr == 1) PG8_BAR;
    PG8_WAIT_V(2); PG8_BAR;
    PG8_STAGE(PG8_SB(1, 0), cB + kstep, voffB); PG8_STAGE_A(PG8_SA(1, 0), kstep, 0, false); PG8_STAGE(PG8_SB(1, 1), cB + hstep + kstep, voffB);
    PG8_WAIT_V(6); PG8_BAR;
    for (;;) {
        const bool has_next = S.next(ui + 1, nxt);
        nA = has_next ? (const char*)g.A + (size_t)nxt.arow * K * 2 : cA; nB = has_next ? (const char*)g.Bt + (size_t)nxt.brow * K * 2 : cB;
        if constexpr (GATHER) { if (has_next) { PG8_GOFF(gN, nxt); } else { gN[0][0] = gC[0][0]; gN[0][1] = gC[0][1]; gN[1][0] = gC[1][0]; gN[1][1] = gC[1][1]; } }
        for (int t = 0; t < nt; t += 2) {
            const bool last = (t == nt - 2);
            const size_t k1 = (size_t)(t + 1) * kstep;
            const size_t k2 = last ? (size_t)0 : (size_t)(t + 2) * kstep;
            const char* b2 = last ? nB : cB + (size_t)(t + 2) * kstep;
            const size_t k3 = k2 + kstep; const char* b3 = b2 + kstep;
            PG8_LDB(B0, 0, 0); PG8_LDB(B1, 0, 1); PG8_SCHED; PG8_LDA(At, 0, 0); PG8_STAGE_A(PG8_SA(1, 1), k1, 1, false);
            PG8_WAIT_V(8); PG8_WAIT_L(0); PG8_BAR; PG8_MMA(0, 0, At, B0); PG8_MMA(0, 1, At, B1); PG8_BAR; PG8_SCHED;
            PG8_LDA(At, 0, 1); PG8_STAGE(PG8_SB(0, 0), b2, voffB); PG8_STAGE(PG8_SB(0, 1), b2 + hstep, voffB); PG8_STAGE_A(PG8_SA(0, 0), k2, 0, last);
            PG8_WAIT_V(8); PG8_WAIT_L(0); PG8_BAR; PG8_MMA(1, 0, At, B0); PG8_MMA(1, 1, At, B1); PG8_BAR; PG8_SCHED;
            PG8_LDB(B0, 1, 0); PG8_LDB(B1, 1, 1); PG8_SCHED; PG8_LDA(At, 1, 0); PG8_STAGE_A(PG8_SA(0, 1), k2, 1, last);
            PG8_WAIT_V(8); PG8_WAIT_L(0); PG8_BAR; PG8_MMA(0, 0, At, B0); PG8_MMA(0, 1, At, B1); PG8_BAR; PG8_SCHED;
            PG8_LDA(At, 1, 1); PG8_STAGE(PG8_SB(1, 0), b3, voffB); PG8_STAGE(PG8_SB(1, 1), b3 + hstep, voffB); PG8_STAGE_A(PG8_SA(1, 0), k3, 0, last);
            PG8_WAIT_V(8); PG8_WAIT_L(0); PG8_BAR; PG8_MMA(1, 0, At, B0); PG8_MMA(1, 1, At, B1); PG8_BAR; PG8_SCHED;
        }
        if (wr == 0) PG8_BAR;
        E(acc, cur, wr, wc, fr, fq);
        if (!has_next) break;
#pragma unroll
        for (int a = 0; a < 2; ++a)
#pragma unroll
            for (int b = 0; b < 2; ++b)
#pragma unroll
                for (int m = 0; m < 4; ++m)
#pragma unroll
                    for (int n = 0; n < 2; ++n) acc[a][b][m][n] = (f32x4){0.f, 0.f, 0.f, 0.f};
        cur = nxt; cA = nA; cB = nB; ++ui;
        if constexpr (GATHER) { gC[0][0] = gN[0][0]; gC[0][1] = gN[0][1]; gC[1][0] = gN[1][0]; gC[1][1] = gN[1][1]; }
        if (wr == 1) PG8_BAR;
    }
    PG8_WAIT_V(0);
    PG8_BAR;
#undef PG8_SA
#undef PG8_SB
#undef PG8_STAGE
#undef PG8_STAGE_A
#undef PG8_LDA
#undef PG8_LDB
#undef PG8_MMA
#undef PG8_WAIT_V
#undef PG8_WAIT_L
#undef PG8_BAR
#undef PG8_SCHED
#undef PG8_GOFF
}
}
namespace pg8 {
template <int MASK> __device__ __forceinline__ float sxor(float v) { return __builtin_bit_cast(float, __builtin_amdgcn_ds_swizzle(__builtin_bit_cast(int, v), (MASK << 10) | 0x1f)); }
__device__ __forceinline__ float sum32(float v) { auto r = __builtin_amdgcn_permlane32_swap(__float_as_uint(v), __float_as_uint(v), false, false); return __uint_as_float(r[0]) + __uint_as_float(r[1]); }
constexpr float RMS_EPS = 1e-6f;
constexpr float QSCALE_C2 = 0.125f * 1.4426950408889634f;

struct EpiInProj {
    bf16_t *q, *k, *v, *su, *sv; const float* rstd1; const float* rope; const float* qg; const float* kg; float* svst;
    __device__ __forceinline__ void operator()(const f32x4 (&acc)[2][2][4][2], const Unit& u, int wr, int wc, int fr, int fq) const {
        const int cls = u.pn >> 1, G = (u.pn & 1) * 4 + wc, colbase = G * 64 + 16 * fq;
        bf16_t* dst = cls == 0 ? q : cls == 1 ? k : cls == 2 ? v : cls == 3 ? su : sv;
        float gain[16];
        if (cls < 2) { const float* gp = (cls == 0 ? qg : kg) + 16 * fq;
#pragma unroll
            for (int i = 0; i < 16; ++i) gain[i] = gp[i]; }
#pragma unroll
        for (int ai = 0; ai < 2; ++ai)
#pragma unroll
            for (int m = 0; m < 4; ++m) {
                const int row = u.pm * BM + ai * HALF + wr * 64 + m * 16 + fr;
                const float rs = rstd1[row];
                float x[16];
#pragma unroll
                for (int bj = 0; bj < 2; ++bj)
#pragma unroll
                    for (int n = 0; n < 2; ++n)
#pragma unroll
                        for (int j = 0; j < 4; ++j) x[8 * bj + 4 * n + j] = acc[ai][bj][m][n][j] * rs;
                if (cls < 2) {
                    float ss = 0.f;
#pragma unroll
                    for (int i = 0; i < 16; ++i) ss += x[i] * x[i];
                    ss += sxor<16>(ss); ss = sum32(ss);
                    const float rn = __builtin_amdgcn_rsqf(ss * (1.0f / 64.0f) + RMS_EPS);
#pragma unroll
                    for (int i = 0; i < 16; ++i) x[i] = x[i] * rn * gain[i];
                    if (fq == 0) {
                        const f32x4 c0 = *(const f32x4*)(rope + (size_t)row * 16), c1 = *(const f32x4*)(rope + (size_t)row * 16 + 4);
                        const f32x4 s0 = *(const f32x4*)(rope + (size_t)row * 16 + 8), s1 = *(const f32x4*)(rope + (size_t)row * 16 + 12);
#pragma unroll
                        for (int i = 0; i < 8; ++i) { const float c = i < 4 ? c0[i & 3] : c1[i & 3], s = i < 4 ? s0[i & 3] : s1[i & 3];
                            const float x1 = x[i], x2 = x[8 + i]; x[i] = x1 * c - x2 * s; x[8 + i] = x1 * s + x2 * c; }
                    }
                    if (cls == 0) {
#pragma unroll
                        for (int i = 0; i < 16; ++i) x[i] *= QSCALE_C2; }
                } else if (cls >= 3) {
#pragma unroll
                    for (int i = 0; i < 16; i += 2) { const f32x2 gv = gelu_pk((f32x2){x[i], x[i + 1]}); x[i] = gv.x; x[i + 1] = gv.y; }
                    if (cls == 4) {
                        float s1 = 0.f, s2 = 0.f;
#pragma unroll
                        for (int i = 0; i < 16; ++i) { s1 += x[i]; s2 += x[i] * x[i]; }
                        s1 += sxor<16>(s1); s1 = sum32(s1); s2 += sxor<16>(s2); s2 = sum32(s2);
                        if (fq == 0) *(f32x2*)(svst + (size_t)row * 16 + G * 2) = (f32x2){s1, s2};
                    }
                }
                u32x4 w0, w1;
                w0.x = cvt_pk_bf16(x[0], x[1]); w0.y = cvt_pk_bf16(x[2], x[3]); w0.z = cvt_pk_bf16(x[4], x[5]); w0.w = cvt_pk_bf16(x[6], x[7]);
                w1.x = cvt_pk_bf16(x[8], x[9]); w1.y = cvt_pk_bf16(x[10], x[11]); w1.z = cvt_pk_bf16(x[12], x[13]); w1.w = cvt_pk_bf16(x[14], x[15]);
                bf16_t* rp = dst + (size_t)row * 512 + colbase;
                *(u32x4*)rp = w0; *(u32x4*)(rp + 8) = w1;
            }
    }
};

struct EpiOutProj {
    const float* x; float* out; bf16_t* hb; float* hst;
    __device__ __forceinline__ void operator()(const f32x4 (&acc)[2][2][4][2], const Unit& u, int wr, int wc, int fr, int fq) const {
#pragma unroll
        for (int ai = 0; ai < 2; ++ai)
#pragma unroll
            for (int m = 0; m < 4; ++m) {
                const int row = u.pm * BM + ai * HALF + wr * 64 + m * 16 + fr;
                float ss = 0.f;
#pragma unroll
                for (int bj = 0; bj < 2; ++bj) {
                    const size_t off = (size_t)row * 1024 + u.pn * BM + bj * HALF + wc * 32 + 8 * fq;
                    const f32x4 h0 = *(const f32x4*)(x + off) + acc[ai][bj][m][0], h1 = *(const f32x4*)(x + off + 4) + acc[ai][bj][m][1];
                    *(f32x4*)(out + off) = h0; *(f32x4*)(out + off + 4) = h1;
                    u32x4 w; w.x = cvt_pk_bf16(h0[0], h0[1]); w.y = cvt_pk_bf16(h0[2], h0[3]); w.z = cvt_pk_bf16(h1[0], h1[1]); w.w = cvt_pk_bf16(h1[2], h1[3]);
                    *(u32x4*)(hb + off) = w;
                    ss += (h0[0] * h0[0] + h0[1] * h0[1]) + (h0[2] * h0[2] + h0[3] * h0[3]) + (h1[0] * h1[0] + h1[1] * h1[1]) + (h1[2] * h1[2] + h1[3] * h1[3]);
                }
                ss += sxor<16>(ss); ss = sum32(ss);
                if (fq == 0) hst[(size_t)row * 16 + u.pn * 4 + wc] = ss;
            }
    }
};

struct EpiMoeUp {
    bf16_t* act; const float* rstd2; const float* pgate;
    __device__ __forceinline__ void operator()(const f32x4 (&acc)[2][2][4][2], const Unit& u, int wr, int wc, int fr, int fq) const {
#pragma unroll
        for (int ai = 0; ai < 2; ++ai)
#pragma unroll
            for (int m = 0; m < 4; ++m) {
                const int rl = ai * HALF + wr * 64 + m * 16 + fr;
                const bool valid = rl < u.nvalid;
                const int p = u.lst[valid ? rl : u.nvalid - 1];
                const float rs = rstd2[p >> 1], gw = pgate[p];
                float a[8];
#pragma unroll
                for (int n = 0; n < 2; ++n)
#pragma unroll
                    for (int j = 0; j < 4; ++j) { const float gt = acc[ai][0][m][n][j] * rs, up = acc[ai][1][m][n][j] * rs;
                        const float sg = gt * __builtin_amdgcn_rcpf(1.0f + __builtin_amdgcn_exp2f(-1.4426950408889634f * gt));
                        a[4 * n + j] = sg * up * gw; }
                u32x4 w; w.x = cvt_pk_bf16(a[0], a[1]); w.y = cvt_pk_bf16(a[2], a[3]); w.z = cvt_pk_bf16(a[4], a[5]); w.w = cvt_pk_bf16(a[6], a[7]);
                if (valid) *(u32x4*)(act + (size_t)(u.arow + rl) * 512 + u.pn * 128 + wc * 32 + 8 * fq) = w;
            }
    }
};

struct EpiMoeDown {
    bf16_t* y;
    __device__ __forceinline__ void operator()(const f32x4 (&acc)[2][2][4][2], const Unit& u, int wr, int wc, int fr, int fq) const {
#pragma unroll
        for (int ai = 0; ai < 2; ++ai)
#pragma unroll
            for (int m = 0; m < 4; ++m) {
                const int rl = ai * HALF + wr * 64 + m * 16 + fr;
                const bool valid = rl < u.nvalid;
                const int p = u.lst[valid ? rl : u.nvalid - 1];
#pragma unroll
                for (int bj = 0; bj < 2; ++bj) {
                    const f32x4 v0 = acc[ai][bj][m][0], v1 = acc[ai][bj][m][1];
                    u32x4 w; w.x = cvt_pk_bf16(v0[0], v0[1]); w.y = cvt_pk_bf16(v0[2], v0[3]); w.z = cvt_pk_bf16(v1[0], v1[1]); w.w = cvt_pk_bf16(v1[2], v1[3]);
                    if (valid) *(u32x4*)(y + (size_t)p * 1024 + u.pn * BM + bj * HALF + wc * 32 + 8 * fq) = w;
                }
            }
    }
};
}
#include <hip/hip_bf16.h>
#include <cmath>
namespace attn_body {
using bf16=__hip_bfloat16;
using bf16x8=__attribute__((ext_vector_type(8)))short;
using s16x4=__attribute__((ext_vector_type(4)))short;
using f32x16=__attribute__((ext_vector_type(16)))float;
using u32x4=__attribute__((ext_vector_type(4)))unsigned;
constexpr int SEQ=2048,D=64,QP=512,KP=512,VP=512,OP=1024;
constexpr int NW=8,QBLK=32,QB=QBLK*NW,KVBLK=64,NQB=SEQ/QB;
constexpr int ATTN_UNIT_ROWS=QB;
__device__ __forceinline__ int crow(int r,int hi){return (r&3)+8*(r>>2)+4*hi;}
#define SBAR() __builtin_amdgcn_sched_barrier(0)
__device__ __forceinline__ void cmask(f32x16&p0,f32x16&p1,int jb,int qrel,int hi){
  const float NEG=-INFINITY; int kb=64*jb+4*hi;
  #pragma unroll
  for(int r=0;r<16;++r){int kv=kb+(r&3)+8*(r>>2); if(kv>qrel)p0[r]=NEG; if(kv+32>qrel)p1[r]=NEG;}
}

constexpr int NSLOT=3, SLOTB=8192;
constexpr int LDS_K=0, LDS_V=NSLOT*SLOTB, LDS_WS=2*NSLOT*SLOTB, LDS_OST=LDS_WS+NW*64*4, LDS_BYTES=LDS_OST+NW*4096;
constexpr float C2=0.125f*1.4426950408889634f;
__device__ __forceinline__ void glds16(const void*gsrc,unsigned lds_dst){unsigned keep;
  asm volatile("s_mov_b32 %0, m0\n\ts_mov_b32 m0, %2\n\ts_nop 0\n\tglobal_load_lds_dwordx4 %1, off\n\ts_mov_b32 m0, %0":"=&s"(keep):"v"(gsrc),"s"(lds_dst):"memory");}
__device__ __forceinline__ float max3f(float a,float b,float c){float r;asm("v_max3_f32 %0, %1, %2, %3":"=v"(r):"v"(a),"v"(b),"v"(c));return r;}
__device__ __forceinline__ float max2f(float a,float b){float r;asm("v_max_f32_e32 %0, %1, %2":"=v"(r):"v"(a),"v"(b));return r;}
__device__ __forceinline__ float fadd_s(float a,float b){float r;asm("v_add_f32_e32 %0, %1, %2":"=v"(r):"v"(a),"v"(b));return r;}
__device__ __forceinline__ float fsub_s(float a,float b){float r;asm("v_sub_f32_e32 %0, %1, %2":"=v"(r):"v"(a),"v"(b));return r;}
typedef float f32x2_t __attribute__((ext_vector_type(2))); typedef __bf16 bf16x2_t __attribute__((ext_vector_type(2)));
__device__ __forceinline__ unsigned cvtpk_s(float lo,float hi){f32x2_t v={lo,hi};bf16x2_t b=__builtin_convertvector(v,bf16x2_t);return __builtin_bit_cast(unsigned,b);}
#define WAIT_BAR(N) asm volatile("s_waitcnt vmcnt(" #N ") lgkmcnt(0)\n\ts_barrier":::"memory")

__device__ __forceinline__ void qkt(f32x16&p0,f32x16&p1,const char*Kslot,const bf16x8*qr,const f32x16&negm,int r32,int hi){
  const char*kb=Kslot+hi*1024+r32*16;
  #pragma unroll
  for(int d0=0;d0<4;++d0){
    const bf16x8 b0=*reinterpret_cast<const bf16x8*>(kb+d0*2048);
    const bf16x8 b1=*reinterpret_cast<const bf16x8*>(kb+d0*2048+512);
    if(d0==0){p0=__builtin_amdgcn_mfma_f32_32x32x16_bf16(b0,qr[0],negm,0,0,0);p1=__builtin_amdgcn_mfma_f32_32x32x16_bf16(b1,qr[0],negm,0,0,0);}
    else{p0=__builtin_amdgcn_mfma_f32_32x32x16_bf16(b0,qr[d0],p0,0,0,0);p1=__builtin_amdgcn_mfma_f32_32x32x16_bf16(b1,qr[d0],p1,0,0,0);}}
}
typedef __attribute__((address_space(3))) const char* lds_cptr;
typedef short v4i16_t __attribute__((ext_vector_type(4)));
__device__ __forceinline__ void kload8(bf16x8*kf,lds_cptr kp){
  kf[0]=*(const __attribute__((address_space(3))) bf16x8*)(kp);      kf[1]=*(const __attribute__((address_space(3))) bf16x8*)(kp+512);
  kf[2]=*(const __attribute__((address_space(3))) bf16x8*)(kp+2048); kf[3]=*(const __attribute__((address_space(3))) bf16x8*)(kp+2560);
  kf[4]=*(const __attribute__((address_space(3))) bf16x8*)(kp+4096); kf[5]=*(const __attribute__((address_space(3))) bf16x8*)(kp+4608);
  kf[6]=*(const __attribute__((address_space(3))) bf16x8*)(kp+6144); kf[7]=*(const __attribute__((address_space(3))) bf16x8*)(kp+6656);
}
__device__ __forceinline__ void kload2(bf16x8*kf,lds_cptr kp,int j){ kf[2*j]=*(const __attribute__((address_space(3))) bf16x8*)(kp+j*2048); kf[2*j+1]=*(const __attribute__((address_space(3))) bf16x8*)(kp+j*2048+512); }
__device__ __forceinline__ s16x4 vtr(lds_cptr p){ return __builtin_bit_cast(s16x4,__builtin_amdgcn_ds_read_tr16_b64_v4i16((__attribute__((address_space(3))) v4i16_t*)p)); }
__device__ __forceinline__ float rowmax(const f32x16&p0,const f32x16&p1){
  float a=max3f(p0[0],p0[1],p1[0]),b=max3f(p0[2],p0[3],p1[1]);a=max3f(a,p1[2],p1[3]);
  #pragma unroll
  for(int r=4;r<16;r+=4){a=max3f(a,p0[r],p0[r+1]);b=max3f(b,p0[r+2],p0[r+3]);a=max3f(a,p1[r],p1[r+1]);b=max3f(b,p1[r+2],p1[r+3]);}
  const float m=max2f(a,b);
  auto rr=__builtin_amdgcn_permlane32_swap(__float_as_uint(m),__float_as_uint(m),false,false);
  return max2f(__uint_as_float(rr[0]),__uint_as_float(rr[1]));
}
__device__ __forceinline__ void pv(f32x16*o,int vb,bf16x8 pa0,bf16x8 pa1,bf16x8 pa2,bf16x8 pa3){
  #pragma unroll
  for(int d0=0;d0<2;++d0){s16x4 lo[4],hi[4];
    #pragma unroll
    for(int ks=0;ks<4;++ks){
      asm volatile("ds_read_b64_tr_b16 %0,%1 offset:%c2":"=&v"(lo[ks]):"v"(vb),"i"(d0*4096+ks*1024):"memory");
      asm volatile("ds_read_b64_tr_b16 %0,%1 offset:%c2":"=&v"(hi[ks]):"v"(vb),"i"(d0*4096+ks*1024+512):"memory");}
    asm volatile("s_waitcnt lgkmcnt(0)":::"memory");SBAR();
    #define PK(k) (bf16x8){lo[k][0],lo[k][1],lo[k][2],lo[k][3],hi[k][0],hi[k][1],hi[k][2],hi[k][3]}
    o[d0]=__builtin_amdgcn_mfma_f32_32x32x16_bf16(pa0,PK(0),o[d0],0,0,0);
    o[d0]=__builtin_amdgcn_mfma_f32_32x32x16_bf16(pa1,PK(1),o[d0],0,0,0);
    o[d0]=__builtin_amdgcn_mfma_f32_32x32x16_bf16(pa2,PK(2),o[d0],0,0,0);
    o[d0]=__builtin_amdgcn_mfma_f32_32x32x16_bf16(pa3,PK(3),o[d0],0,0,0);
    #undef PK
  }
}

#ifndef ATTN_STORE16
#define ATTN_STORE16(p,v) (*(u32x4*)(p)=(v))
#endif
__device__ __forceinline__ int olane(){ int l=(int)__builtin_amdgcn_mbcnt_hi(~0u,__builtin_amdgcn_mbcnt_lo(~0u,0u)); asm volatile("":"+v"(l)); return l; }
template<int THRL> __device__ __forceinline__ void attn_unit(const int wid,long rowbase,int qb,const bf16*Qc,const bf16*__restrict__ Kc,const bf16*__restrict__ Vc,bf16*Oc,char*shm){
  const int lane=olane(),r32=lane&31,hi=lane>>5;
  const int q0=qb*QB;
  const bf16*Qw=Qc+(rowbase+q0+wid*QBLK)*QP;
  const bf16*Kh=Kc+rowbase*KP,*Vh=Vc+rowbase*VP;
  const unsigned lds0=(unsigned)(uintptr_t)shm;
  float*wsf=(float*)(shm+LDS_WS)+wid*64;
  const bf16*ksrc=Kh+(long)lane*KP+wid*8;
  const bf16*vsrc=Vh+(long)(16*(wid&3)+(lane>>2))*VP+(wid>>2)*32+(lane&3)*8;
  const unsigned kdst=lds0+LDS_K+wid*1024, vdst=lds0+LDS_V+wid*1024;
  #define DMA_K(t,slot) glds16(ksrc+(long)(t)*KVBLK*KP,(unsigned)__builtin_amdgcn_readfirstlane(kdst+(slot)))
  #define DMA_V(t,slot) glds16(vsrc+(long)(t)*KVBLK*VP,(unsigned)__builtin_amdgcn_readfirstlane(vdst+(slot)))
  const int vb0=(int)(lds0+LDS_V)+((lane>>4)&1)*32+(lane&3)*8+(4*hi+((lane&15)>>2))*64;
  const char*Kbase=shm+LDS_K; bf16x8 kf[8];
  const lds_cptr shm3=(lds_cptr)shm; const lds_cptr kp0=shm3+LDS_K+hi*1024+r32*16; const lds_cptr vp0=shm3+LDS_V+((lane>>4)&1)*32+(lane&3)*8+(4*hi+((lane&15)>>2))*64;
  const int NT=(q0+QB)/KVBLK;
  DMA_K(0,0);DMA_V(0,0);DMA_K(1,SLOTB);
  bf16x8 qr[4];
  #pragma unroll
  for(int d0=0;d0<4;++d0)qr[d0]=*reinterpret_cast<const bf16x8*>(&Qw[(long)r32*QP+d0*16+hi*8]);
  float l_reg=0.f;f32x16 o[2];o[0]=f32x16{};o[1]=f32x16{};const f32x16 negm=f32x16{};
  const int qrel=wid*QBLK+r32;
  #define CMASK(P0,P1,t) do{int jb_=(t)-(NT-4); if(jb_>=0)cmask(P0,P1,jb_,qrel,hi);}while(0)
  #define START(P0,P1) do{ _Pragma("unroll") for(int r=0;r<16;++r)P0[r]=__builtin_amdgcn_exp2f(P0[r]); }while(0)
  #define RESC() do{}while(0)
  f32x16 pA0,pA1,pB0,pB1;
  int sl_prev=0,sl_cur=0,sl_next=SLOTB;
  #define ROT() do{sl_prev=sl_cur;sl_cur=sl_next;sl_next=(sl_next==(NSLOT-1)*SLOTB)?0:sl_next+SLOTB;}while(0)
  DMA_K(2,2*SLOTB);
  WAIT_BAR(3);
  qkt(pA0,pA1,Kbase,qr,negm,r32,hi);asm volatile("s_nop 15\n\ts_nop 7":"+v"(pA0),"+v"(pA1));CMASK(pA0,pA1,0);
  START(pA0,pA1);
  _Pragma("unroll") for(int r=0;r<16;++r)pA1[r]=__builtin_amdgcn_exp2f(pA1[r]);
  WAIT_BAR(0);
  DMA_K(3,0);DMA_V(1,SLOTB);
  ROT();
  kload8(kf,kp0+sl_cur);
  WAIT_BAR(2);
  s16x4 vlo[8],vhi[8]; u32x4 pw0,pw1,pw2,pw3;
  #define PKW(P,B) cvtpk_s(P[B],P[B+1])
  #define PAF(k) __builtin_bit_cast(bf16x8,pw##k)
  #define VFR(i) (bf16x8){vlo[i][0],vlo[i][1],vlo[i][2],vlo[i][3],vhi[i][0],vhi[i][1],vhi[i][2],vhi[i][3]}
  #define PIN(x) asm volatile("":"+v"(x))
  #define MX3(a,b,c) __builtin_fmaxf(__builtin_fmaxf((a),(b)),(c))
  #define GAPA(MF,A0,A1,A2,A3,W0,W1,PW) do{ MF; sacc+=A0; sacc+=A1; sacc+=A2; sacc+=A3; PIN(sacc); W0; W1; PIN(PW); SBAR(); }while(0)
  #define EX(v) __builtin_amdgcn_exp2f(v)
  #define GAPB(MF,X,B) do{ MF; X[B]=EX(X[B]); X[B+1]=EX(X[B+1]); X[B+2]=EX(X[B+2]); X[B+3]=EX(X[B+3]); PIN(X); SBAR(); }while(0)
  #define VRD(i) do{ vlo[i]=vtr(vp_+(((i)>>2)*4096+((i)&3)*1024)); vhi[i]=vtr(vp_+(((i)>>2)*4096+((i)&3)*1024+512)); }while(0)
  #define KRD(G,j) do{ if(G){ kload2(kf,kp0+sl_next,j); SBAR(); } }while(0)
  #define STEP(C0,C1,P0,P1,t,GK,GV,GL) do{ SBAR(); \
    const lds_cptr vp_=vp0+sl_prev; \
    VRD(0); SBAR(); float sacc=(P0[0]+P0[1]); \
    GAPA(C0=__builtin_amdgcn_mfma_f32_32x32x16_bf16(kf[0],qr[0],negm,0,0,0), P0[2],P0[3],P0[4],P0[5],     pw0[0]=PKW(P0,0), pw0[1]=PKW(P0,2), pw0); \
    VRD(4); SBAR(); GAPA(C1=__builtin_amdgcn_mfma_f32_32x32x16_bf16(kf[1],qr[0],negm,0,0,0), P0[6],P0[7],P0[8],P0[9],     pw0[2]=PKW(P0,4), pw0[3]=PKW(P0,6), pw0); \
    VRD(1); SBAR(); GAPA(C0=__builtin_amdgcn_mfma_f32_32x32x16_bf16(kf[2],qr[1],C0,0,0,0),   P0[10],P0[11],P0[12],P0[13], pw1[0]=PKW(P0,8), pw1[1]=PKW(P0,10), pw1); \
    VRD(5); SBAR(); GAPA(C1=__builtin_amdgcn_mfma_f32_32x32x16_bf16(kf[3],qr[1],C1,0,0,0),   P0[14],P0[15],P1[0],P1[1],   pw1[2]=PKW(P0,12),pw1[3]=PKW(P0,14), pw1); \
    VRD(2); SBAR(); GAPA(C0=__builtin_amdgcn_mfma_f32_32x32x16_bf16(kf[4],qr[2],C0,0,0,0),   P1[2],P1[3],P1[4],P1[5],     pw2[0]=PKW(P1,0), pw2[1]=PKW(P1,2), pw2); \
    VRD(6); SBAR(); GAPA(C1=__builtin_amdgcn_mfma_f32_32x32x16_bf16(kf[5],qr[2],C1,0,0,0),   P1[6],P1[7],P1[8],P1[9],     pw2[2]=PKW(P1,4), pw2[3]=PKW(P1,6), pw2); \
    VRD(3); SBAR(); GAPA(C0=__builtin_amdgcn_mfma_f32_32x32x16_bf16(kf[6],qr[3],C0,0,0,0),   P1[10],P1[11],P1[12],P1[13], pw3[0]=PKW(P1,8), pw3[1]=PKW(P1,10), pw3); \
    VRD(7); SBAR(); GAPA(C1=__builtin_amdgcn_mfma_f32_32x32x16_bf16(kf[7],qr[3],C1,0,0,0),   P1[14],P1[15],0.f,0.f,       pw3[2]=PKW(P1,12),pw3[3]=PKW(P1,14), pw3); \
    l_reg+=sacc; \
    if(GK){DMA_K((t)+3,sl_cur);} if(GV){DMA_V((t)+1,sl_next);} \
    CMASK(C0,C1,t); \
    SBAR(); \
    GAPB(o[0]=__builtin_amdgcn_mfma_f32_32x32x16_bf16(PAF(0),VFR(0),o[0],0,0,0), C0,0); \
    GAPB(o[1]=__builtin_amdgcn_mfma_f32_32x32x16_bf16(PAF(0),VFR(4),o[1],0,0,0), C0,4); \
    KRD(GL,0); GAPB(o[0]=__builtin_amdgcn_mfma_f32_32x32x16_bf16(PAF(1),VFR(1),o[0],0,0,0), C0,8); \
    KRD(GL,1); GAPB(o[1]=__builtin_amdgcn_mfma_f32_32x32x16_bf16(PAF(1),VFR(5),o[1],0,0,0), C0,12); \
    KRD(GL,2); GAPB(o[0]=__builtin_amdgcn_mfma_f32_32x32x16_bf16(PAF(2),VFR(2),o[0],0,0,0), C1,0); \
    KRD(GL,3); GAPB(o[1]=__builtin_amdgcn_mfma_f32_32x32x16_bf16(PAF(2),VFR(6),o[1],0,0,0), C1,4); \
    GAPB(o[0]=__builtin_amdgcn_mfma_f32_32x32x16_bf16(PAF(3),VFR(3),o[0],0,0,0), C1,8); \
    GAPB(o[1]=__builtin_amdgcn_mfma_f32_32x32x16_bf16(PAF(3),VFR(7),o[1],0,0,0), C1,12); \
    }while(0)
  int t=1;
  #undef CMASK
  #define CMASK(P0,P1,t) do{}while(0)
  for(;t+5<NT;t+=2){
    STEP(pB0,pB1,pA0,pA1,t,true,true,true);     WAIT_BAR(2); RESC(); ROT();
    STEP(pA0,pA1,pB0,pB1,t+1,true,true,true);   WAIT_BAR(2); RESC(); ROT();
  }
  #undef CMASK
  #define CMASK(P0,P1,t) do{int jb_=(t)-(NT-4); if(jb_>=0)cmask(P0,P1,jb_,qrel,hi);}while(0)
  #define ENDW(tt) do{ if((tt)+3<NT){WAIT_BAR(2);} else if((tt)+2<NT){WAIT_BAR(1);} else {WAIT_BAR(0);} }while(0)
  for(;t+1<NT;t+=2){
    STEP(pB0,pB1,pA0,pA1,t,(t+3<NT),(t+1<NT),(t+1<NT));       ENDW(t);   RESC(); ROT();
    STEP(pA0,pA1,pB0,pB1,t+1,(t+4<NT),(t+2<NT),(t+2<NT));     ENDW(t+1); RESC(); ROT();
  }
  STEP(pB0,pB1,pA0,pA1,NT-1,false,false,false); RESC();
  { float sacc=pB0[0]+pB0[1]; _Pragma("unroll") for(int r=2;r<16;++r)sacc+=pB0[r]; _Pragma("unroll") for(int r=0;r<16;++r)sacc+=pB1[r]; l_reg+=sacc;
    pw0=(u32x4){PKW(pB0,0),PKW(pB0,2),PKW(pB0,4),PKW(pB0,6)};pw1=(u32x4){PKW(pB0,8),PKW(pB0,10),PKW(pB0,12),PKW(pB0,14)};pw2=(u32x4){PKW(pB1,0),PKW(pB1,2),PKW(pB1,4),PKW(pB1,6)};pw3=(u32x4){PKW(pB1,8),PKW(pB1,10),PKW(pB1,12),PKW(pB1,14)};
    SBAR(); pv(o,vb0+sl_cur,PAF(0),PAF(1),PAF(2),PAF(3)); }
  #undef PKW
  #undef PAF
  #undef VFR
  #undef PIN
  #undef MX3
  #undef GAPA
  #undef GAPB
  #undef EX
  #undef VRD
  #undef KRD
  #undef STEP
  #undef ENDW
  {auto rr=__builtin_amdgcn_permlane32_swap(__float_as_uint(l_reg),__float_as_uint(l_reg),false,false);l_reg=__uint_as_float(rr[0])+__uint_as_float(rr[1]);}
  const int le=olane(),r32e=le&31,hie=le>>5;
  if(hie==0)wsf[32+r32e]=l_reg;asm volatile("s_waitcnt lgkmcnt(0)":::"memory");
  float rli[16];
  #pragma unroll
  for(int r=0;r<16;++r)rli[r]=__builtin_amdgcn_rcpf(wsf[32+crow(r,hie)]);
  bf16*Ow=Oc+(rowbase+q0+wid*QBLK)*OP;
  { bf16*stg=(bf16*)(shm+LDS_OST)+wid*2048;
    #pragma unroll
    for(int r=0;r<16;++r){const int orow=crow(r,hie);
      #pragma unroll
      for(int d0=0;d0<2;++d0)stg[orow*64+d0*32+r32e]=__float2bfloat16(o[d0][r]*rli[r]);}
    asm volatile("s_waitcnt lgkmcnt(0)":::"memory");
    #pragma unroll
    for(int i=0;i<4;++i){const int row=i*8+(le>>3),ch=le&7; const u32x4 v=*(const u32x4*)(stg+row*64+ch*8); ATTN_STORE16(Ow+(long)row*OP+ch*8,v);} }
  asm volatile("s_waitcnt lgkmcnt(0)\n\ts_barrier":::"memory");
  #undef DMA_K
  #undef DMA_V
  #undef CMASK
  #undef START
  #undef RESC
  #undef ROT
}
constexpr int ATTN_LDS_BYTES=LDS_BYTES;
#undef SBAR
#undef WAIT_BAR
}
constexpr int NWAVES = 8;
constexpr int NPH = 8;
#ifndef MK_N_LAUNCHES
#define MK_N_LAUNCHES 1
#endif
constexpr int N_LAUNCHES = MK_N_LAUNCHES;
static_assert(N_LAUNCHES == 1 || N_LAUNCHES == NPH, "MK_N_LAUNCHES is 1 or 8");

constexpr int BATCH = 16, SEQ = 2048, T = BATCH * SEQ, D = 1024, INC = 2560, NE = 32, FF = 512, ECAP = T;
constexpr float RMS_EPS = 1e-6f;
constexpr float LAMBDA_INIT = 0.2f;

constexpr size_t MiB = 1u << 20;
constexpr size_t WS_CTL = 0, CTL_ZERO_BYTES = 65536;
constexpr size_t WS_WIN = 2 * MiB;
constexpr size_t WS_WOUT = 7 * MiB;
constexpr size_t WS_WR = 9 * MiB;
constexpr size_t WS_SGW = 10 * MiB;
constexpr size_t WS_ROPE = 11 * MiB;
constexpr size_t WS_RSTD1 = 13 * MiB;
constexpr size_t WS_RSTD2 = 13 * MiB + 512 * 1024;
constexpr size_t WS_SVST = 14 * MiB;
constexpr size_t WS_HST = 16 * MiB;
constexpr size_t WS_ELIST = 18 * MiB;
constexpr size_t WS_PGATE = 22 * MiB;
constexpr size_t WS_W1 = 24 * MiB;
constexpr size_t WS_W2 = 88 * MiB;
constexpr size_t WS_XB = 120 * MiB;
constexpr size_t WS_Q = 184 * MiB, WS_K = 216 * MiB, WS_V = 248 * MiB, WS_SU = 280 * MiB, WS_SV = 312 * MiB;
constexpr size_t WS_Y = 184 * MiB;
constexpr size_t WS_MIX = 344 * MiB;
constexpr size_t WS_HB = 408 * MiB;
constexpr size_t WS_END = 472 * MiB;
constexpr int CW_TMO = 0, CW_CODE = 1;
constexpr int CW_BAR = 4096;
constexpr int CW_CNT = 8192;
static_assert((CW_CNT + 64 * NE) * 4 <= (int)CTL_ZERO_BYTES, "CTL words inside the memset region");

constexpr int RING_OFF = 0, RING_BYTES = 131072;
constexpr int LCTL_OFF = RING_BYTES;
constexpr int L_MISC = LCTL_OFF, L_TSTART = LCTL_OFF + 64, L_RSTART = LCTL_OFF + 256, L_CNT = LCTL_OFF + 448, L_HIST = LCTL_OFF + 576, L_BASE = LCTL_OFF + 704;
constexpr int LDS_BYTES = 147456;
#define GAS __attribute__((address_space(1)))
#define LAS __attribute__((address_space(3)))
typedef unsigned short bf16;
typedef unsigned v4u __attribute__((ext_vector_type(4)));
typedef float f32x4 __attribute__((ext_vector_type(4)));
typedef short bf16x8 __attribute__((ext_vector_type(8)));
typedef GAS unsigned gu32;
typedef GAS unsigned long long gu64;
#define RLX_AGENT __ATOMIC_RELAXED, __HIP_MEMORY_SCOPE_AGENT
#define LDS_WAIT() asm volatile("s_waitcnt lgkmcnt(0)" ::: "memory")
#define VM_WAIT() asm volatile("s_waitcnt vmcnt(0)" ::: "memory")
__device__ __forceinline__ unsigned long long rt() { return __builtin_amdgcn_s_memrealtime(); }
__device__ __forceinline__ unsigned f2bf(float f) { unsigned u = __builtin_bit_cast(unsigned, f); return (u + 0x7fffu + ((u >> 16) & 1u)) >> 16; }
__device__ __forceinline__ unsigned pk2(float lo, float hi) { return f2bf(lo) | (f2bf(hi) << 16); }

#define XB_TMO      128
#define XB_XCNT(j)  (256  + 64 * (j))
#define XB_XSUB(j)  (1280 + 64 * (j))
#define XB_XGEN(j)  (2304 + 64 * (j))
#define XB_TOP      3328
#define XB_TOPGEN   3392
#define XCD_BAR_WORDS 3456
#define XB_SPIN_CAP (1u << 18)

__device__ __forceinline__ unsigned xb_ld(unsigned* p)              { return __hip_atomic_load(p, __ATOMIC_RELAXED, __HIP_MEMORY_SCOPE_AGENT); }
__device__ __forceinline__ unsigned xb_add(unsigned* p, unsigned v) { return __hip_atomic_fetch_add(p, v, __ATOMIC_RELAXED, __HIP_MEMORY_SCOPE_AGENT); }
__device__ __forceinline__ unsigned xb_xcc_id() { return (unsigned)__builtin_amdgcn_s_getreg((3 << 11) | 20) & 0xFu; }
#define XB_SPIN(cond, bar) do { unsigned _sp = 0; while (cond) { __builtin_amdgcn_s_sleep(1); \
    if ((++_sp & 255u) == 0u) { if (xb_ld(&(bar)[XB_TMO])) break; if (_sp > XB_SPIN_CAP) { atomicAdd(&(bar)[XB_TMO], 1u); break; } } } } while (0)

struct XcdBarrier {
    unsigned* bar; unsigned x;
    volatile LAS unsigned* st;
};

__device__ __forceinline__ XcdBarrier xcd_barrier_post(unsigned* bar, volatile LAS unsigned* st, const bool t0  ) {
    XcdBarrier b; b.bar = bar; b.x = xb_xcc_id(); b.st = st;
    if (t0) (void)xb_add(&bar[XB_XCNT(b.x)], 1u);
    return b;
}
__device__ __forceinline__ void xcd_barrier_complete(unsigned* bar, unsigned x, unsigned& nloc, unsigned& nx) {
    const unsigned G = gridDim.x * gridDim.y * gridDim.z;
    unsigned sum, cnt, mine, sp = 0u;
    for (;;) {
        sum = 0u; cnt = 0u; mine = 0u;
#pragma unroll
        for (unsigned j = 0; j < 16; ++j) { const unsigned c = xb_ld(&bar[XB_XCNT(j)]); sum += c; cnt += (c > 0u) ? 1u : 0u; mine = (j == x) ? c : mine; }
        if (sum == G) break;
        __builtin_amdgcn_s_sleep(1);
        if ((++sp & 255u) == 0u) { if (xb_ld(&bar[XB_TMO])) break; if (sp > XB_SPIN_CAP) { atomicAdd(&bar[XB_TMO], 1u); break; } }
    }
    nloc = mine > 0u ? mine : 1u; nx = cnt > 0u ? cnt : 1u;
}

__device__ __forceinline__ void xcd_barrier(const XcdBarrier& b, const bool t0  ) {
    asm volatile("s_waitcnt vmcnt(0)" ::: "memory");
    __syncthreads();
    if (t0) {
        unsigned* bar = b.bar;
        __builtin_amdgcn_s_waitcnt(0);
        unsigned nloc = b.st[0], nx = b.st[1];
        if (nloc == 0u) { xcd_barrier_complete(bar, b.x, nloc, nx); b.st[0] = nloc; b.st[1] = nx; }
        const unsigned old = xb_add(&bar[XB_XSUB(b.x)], 1u);
        const unsigned gen = old / nloc;
        if (old + 1u == (gen + 1u) * nloc) {
            __builtin_amdgcn_fence(__ATOMIC_RELEASE, "agent");
            asm volatile("s_waitcnt vmcnt(0)" ::: "memory");
            const unsigned og = xb_add(&bar[XB_TOP], 1u);
            const unsigned tg = og / nx;
            if (og + 1u == (tg + 1u) * nx) xb_add(&bar[XB_TOPGEN], 1u);
            else XB_SPIN(xb_ld(&bar[XB_TOPGEN]) == tg, bar);
            __builtin_amdgcn_fence(__ATOMIC_ACQUIRE, "agent");
            xb_add(&bar[XB_XGEN(b.x)], 1u);
            asm volatile("s_waitcnt vmcnt(0)" ::: "memory");
        } else {
            XB_SPIN(xb_ld(&bar[XB_XGEN(b.x)]) == gen, bar);
            __builtin_amdgcn_fence(__ATOMIC_ACQUIRE, "agent");
            asm volatile("s_waitcnt vmcnt(0)" ::: "memory");
        }
    }
    __syncthreads();
}
typedef unsigned u32x2_t __attribute__((ext_vector_type(2)));
typedef float f32x2_t __attribute__((ext_vector_type(2)));
struct InvFreq { float f[8]; };
struct Args { const float* in[25]; float* out; unsigned char* ws; InvFreq ifq; int ph_lo, ph_hi; };
struct Frame {
    LAS unsigned char* lds;
    gu32* ctl;
    int wave;
    int vcu, G;
    float* out; unsigned char* ws;
};
__device__ __forceinline__ int olane() { int l = (int)__builtin_amdgcn_mbcnt_hi(~0u, __builtin_amdgcn_mbcnt_lo(~0u, 0u)); asm volatile("" : "+v"(l)); return l; }
#define otid() (F.wave * 64 + olane())
template <int MASK> __device__ __forceinline__ float sxor(float v) { return __builtin_bit_cast(float, __builtin_amdgcn_ds_swizzle(__builtin_bit_cast(int, v), (MASK << 10) | 0x1f)); }
__device__ __forceinline__ float sum32(float v) { auto r = __builtin_amdgcn_permlane32_swap(__float_as_uint(v), __float_as_uint(v), false, false); return __uint_as_float(r[0]) + __uint_as_float(r[1]); }
__device__ __forceinline__ float wave_sum(float v) { v += sxor<1>(v); v += sxor<2>(v); v += sxor<4>(v); v += sxor<8>(v); v += sxor<16>(v); return sum32(v); }
__device__ __forceinline__ float bflo(unsigned w) { return __uint_as_float(w << 16); }
__device__ __forceinline__ float bfhi(unsigned w) { return __uint_as_float(w & 0xffff0000u); }
__device__ __forceinline__ unsigned cvtpk(float lo, float hi) { return pg8::cvt_pk_bf16(lo, hi); }

struct RmIn  { __device__ __forceinline__ int operator()(int n) const { const int G = n >> 6, lc = n & 63, fq = lc >> 4, bj = (lc >> 3) & 1, e = lc & 7, pn = G >> 2, wc = G & 3; return 256 * pn + 128 * bj + 32 * wc + 8 * fq + e; } };
struct RmId  { __device__ __forceinline__ int operator()(int n) const { return n; } };
struct RmGU  { int add; __device__ __forceinline__ int operator()(int f) const { return (f >> 7) * 256 + add + (f & 127); } };
template <class RM> __device__ __forceinline__ void p0_transpose_item(const float* W, int N, const float* gk, bf16* WT, int Kd, const RM rm, LAS float* scr, int item, int lane) {
    const int nblk = N / 32, kb = item / nblk, nb = item % nblk, k0 = 64 * kb, n0 = 32 * nb;
#pragma unroll 8
    for (int i = 0; i < 32; ++i) { const int kk = 2 * i + (lane >> 5); const float sc = gk ? gk[k0 + kk] : 1.0f; scr[kk * 33 + (lane & 31)] = W[(size_t)(k0 + kk) * N + n0 + (lane & 31)] * sc; }
    LDS_WAIT(); asm volatile("" ::: "memory");
    const int c = lane & 7;
#pragma unroll
    for (int j = 0; j < 4; ++j) { const int n = (lane >> 3) + 8 * j; const LAS float* s = scr + (8 * c) * 33 + n;
        v4u o; o.x = pk2(s[0 * 33], s[1 * 33]); o.y = pk2(s[2 * 33], s[3 * 33]); o.z = pk2(s[4 * 33], s[5 * 33]); o.w = pk2(s[6 * 33], s[7 * 33]);
        *(GAS v4u*)(WT + (size_t)rm(n0 + n) * Kd + k0 + 8 * c) = o; }
    LDS_WAIT(); asm volatile("" ::: "memory");
}
__device__ __forceinline__ void sincos_acc(float ang, float& s, float& c) {
    const double a = (double)ang, kq = __builtin_rint(a * 0.63661977236758134308), r = a - kq * 1.57079632679489661923;
    const float rf = (float)r, z = rf * rf;
    const float sp = rf + rf * z * (-1.6666654611e-1f + z * (8.3321608736e-3f + z * (-1.9515295891e-4f)));
    const float cp = 1.0f - 0.5f * z + z * z * (4.166664568298827e-2f + z * (-1.388731625493765e-3f + z * 2.443315711809948e-5f));
    const int q = ((int)kq) & 3;
    s = (q == 0) ? sp : (q == 1) ? cp : (q == 2) ? -sp : -cp;
    c = (q == 0) ? cp : (q == 1) ? -sp : (q == 2) ? -cp : sp;
}
__device__ __forceinline__ void p0_prologue(Frame& F, const Args& A) {
    LAS float* scr = (LAS float*)(F.lds + RING_OFF + F.wave * 16384);
    const int lane = otid() & 63;
    const int gw = F.vcu * NWAVES + F.wave, NGW = F.G * NWAVES;
    unsigned char* ws = F.ws;
    { const float* x = A.in[0]; bf16* XB = (bf16*)(ws + WS_XB); float* rstd1 = (float*)(ws + WS_RSTD1);
      for (int m = gw; m < T; m += NGW) {
        const GAS f32x4* xr = (const GAS f32x4*)(x + (size_t)m * D) + lane;
        f32x4 v[4]; float s2 = 0.f;
#pragma unroll
        for (int j = 0; j < 4; ++j) { v[j] = xr[64 * j]; s2 += (v[j].x * v[j].x + v[j].y * v[j].y) + (v[j].z * v[j].z + v[j].w * v[j].w); }
        const float rstd = 1.0f / sqrtf(wave_sum(s2) * (1.f / D) + RMS_EPS);
        GAS u32x2_t* o8 = (GAS u32x2_t*)(XB + (size_t)m * D) + lane;
#pragma unroll
        for (int j = 0; j < 4; ++j) o8[64 * j] = (u32x2_t){cvtpk(v[j].x, v[j].y), cvtpk(v[j].z, v[j].w)};
        if (lane == 0) rstd1[m] = rstd;
      } }
    constexpr int I_IN = (D / 64) * (INC / 32), I_OUT = (D / 64) * (D / 32), I_GU = (D / 64) * (FF / 32), I_DN = (FF / 64) * (D / 32);
    constexpr int NITEMS = I_IN + I_OUT + NE * (2 * I_GU + I_DN);
    for (int it = gw; it < NITEMS; it += NGW) {
        int r = it;
        if (r < I_IN) { p0_transpose_item(A.in[3], INC, A.in[2], (bf16*)(ws + WS_WIN), D, RmIn{}, scr, r, lane); continue; } r -= I_IN;
        if (r < I_OUT) { p0_transpose_item(A.in[16], D, (const float*)nullptr, (bf16*)(ws + WS_WOUT), D, RmId{}, scr, r, lane); continue; } r -= I_OUT;
        const int e = r / (2 * I_GU + I_DN); r -= e * (2 * I_GU + I_DN);
        if (r < I_GU) { p0_transpose_item(A.in[22] + (size_t)e * D * FF, FF, A.in[17], (bf16*)(ws + WS_W1) + (size_t)e * 1024 * 1024, D, RmGU{0}, scr, r, lane); continue; } r -= I_GU;
        if (r < I_GU) { p0_transpose_item(A.in[23] + (size_t)e * D * FF, FF, A.in[17], (bf16*)(ws + WS_W1) + (size_t)e * 1024 * 1024, D, RmGU{128}, scr, r, lane); continue; } r -= I_GU;
        p0_transpose_item(A.in[24] + (size_t)e * FF * D, D, (const float*)nullptr, (bf16*)(ws + WS_W2) + (size_t)e * 1024 * 512, FF, RmId{}, scr, r, lane);
    }
    const int gt = gw * 64 + lane, NGT = NGW * 64;
    { bf16* WR = (bf16*)(ws + WS_WR); const float* g = A.in[17]; const float* wg = A.in[18]; const float* we = A.in[20];
      for (int i = gt; i < 48 * 1024; i += NGT) { const int j = i >> 10, k = i & 1023; float v = 0.f; if (j < 32) v = we[k * 32 + j] * g[k]; else if (j < 36) v = wg[k * 4 + (j - 32)] * g[k]; WR[i] = (bf16)f2bf(v); } }
    { bf16* SGW = (bf16*)(ws + WS_SGW); const float* w = A.in[13];
      for (int i = gt; i < 4 * 128 * 128; i += NGT) { const int t = (i >> 7) & 127, s = i & 127; SGW[i] = (bf16)f2bf(s <= t ? w[i] : 0.f); } }
    { float* rope = (float*)(ws + WS_ROPE); const int* pos = (const int*)A.in[1];
      for (int i = gt; i < T * 8; i += NGT) { const int m = i >> 3, j = i & 7; const float ang = (float)pos[m] * A.ifq.f[j]; float s, c; sincos_acc(ang, s, c); rope[m * 16 + j] = c; rope[m * 16 + 8 + j] = s; } }
}

__device__ __forceinline__ void attn_combine(long tok0, int h, const bf16* Oraw, bf16* mix, const float* g, float lam) {
    const int lane = olane();
    asm volatile("s_waitcnt vmcnt(0)" ::: "memory");
    const int ch = lane & 7;
    f32x4 g0a = *(const f32x4*)(g + ch * 8), g0b = *(const f32x4*)(g + ch * 8 + 4), g1a = *(const f32x4*)(g + 64 + ch * 8), g1b = *(const f32x4*)(g + 64 + ch * 8 + 4);
#pragma unroll
    for (int i = 0; i < 4; ++i) {
        const long tok = tok0 + i * 8 + (lane >> 3);
        const bf16* src = Oraw + tok * 1024 + h * 256 + ch * 8;
        const v4u a00 = *(const GAS v4u*)(src), a01 = *(const GAS v4u*)(src + 64), a10 = *(const GAS v4u*)(src + 128), a11 = *(const GAS v4u*)(src + 192);
        float d0[8], d1[8]; float ss = 0.f;
#pragma unroll
        for (int j = 0; j < 4; ++j) {
            d0[2 * j] = bflo(a00[j]) - lam * bflo(a10[j]); d0[2 * j + 1] = bfhi(a00[j]) - lam * bfhi(a10[j]);
            d1[2 * j] = bflo(a01[j]) - lam * bflo(a11[j]); d1[2 * j + 1] = bfhi(a01[j]) - lam * bfhi(a11[j]);
            ss += d0[2 * j] * d0[2 * j] + d0[2 * j + 1] * d0[2 * j + 1] + d1[2 * j] * d1[2 * j] + d1[2 * j + 1] * d1[2 * j + 1]; }
        ss += sxor<1>(ss); ss += sxor<2>(ss); ss += sxor<4>(ss);
        const float rn = (1.0f - LAMBDA_INIT) / sqrtf(ss * (1.0f / 128.0f) + RMS_EPS);
        v4u o0, o1;
        o0.x = cvtpk(d0[0] * rn * g0a[0], d0[1] * rn * g0a[1]); o0.y = cvtpk(d0[2] * rn * g0a[2], d0[3] * rn * g0a[3]); o0.z = cvtpk(d0[4] * rn * g0b[0], d0[5] * rn * g0b[1]); o0.w = cvtpk(d0[6] * rn * g0b[2], d0[7] * rn * g0b[3]);
        o1.x = cvtpk(d1[0] * rn * g1a[0], d1[1] * rn * g1a[1]); o1.y = cvtpk(d1[2] * rn * g1a[2], d1[3] * rn * g1a[3]); o1.z = cvtpk(d1[4] * rn * g1b[0], d1[5] * rn * g1b[1]); o1.w = cvtpk(d1[6] * rn * g1b[2], d1[7] * rn * g1b[3]);
        bf16* dst = mix + tok * 1024 + h * 128 + ch * 8;
        *(GAS v4u*)dst = o0; *(GAS v4u*)(dst + 64) = o1;
    }
}
__device__ __forceinline__ void sgu_unit(Frame& F, const Args& A, int b, int c, int g) {
    constexpr int VP = 136;
    LAS unsigned short* vnT = (LAS unsigned short*)(F.lds + RING_OFF);
    unsigned char* ws = F.ws;
    const int tid = otid(), lane = tid & 63, wid = F.wave;
    { const int s = tid >> 2, seg = tid & 3; const long tok = (long)b * SEQ + c * 128 + s;
      const float* st = (const float*)(ws + WS_SVST) + tok * 16;
      float sum = 0.f, sq = 0.f;
#pragma unroll
      for (int i = 0; i < 4; ++i) { const f32x4 p = *(const GAS f32x4*)(st + 4 * i); sum += p.x + p.z; sq += p.y + p.w; }
      const float mean = sum * (1.0f / 512.0f), var = sq * (1.0f / 512.0f) - mean * mean, rstd = 1.0f / sqrtf(var + RMS_EPS);
      const bf16* src = (const bf16*)(ws + WS_SV) + tok * 512 + g * 128 + seg * 32;
      const float* lg = A.in[11] + g * 128 + seg * 32; const float* lb = A.in[12] + g * 128 + seg * 32;
#pragma unroll
      for (int j = 0; j < 4; ++j) { const v4u w = *(const GAS v4u*)(src + 8 * j);
#pragma unroll
        for (int e = 0; e < 8; ++e) { const float xv = (e & 1) ? bfhi(w[e >> 1]) : bflo(w[e >> 1]); const int d = seg * 32 + j * 8 + e;
            const float y = (xv - mean) * rstd * lg[j * 8 + e] + lb[j * 8 + e]; vnT[d * VP + s] = (unsigned short)f2bf(y); } } }
    __syncthreads();
    const int fr = lane & 15, fq = lane >> 4;
    f32x4 acc[8];
#pragma unroll
    for (int i = 0; i < 8; ++i) acc[i] = (f32x4){0.f, 0.f, 0.f, 0.f};
    const int nks = (wid >> 1) + 1;
    const bf16* Wg = (const bf16*)(ws + WS_SGW) + g * 16384 + (16 * wid + fr) * 128 + 8 * fq;
    for (int ks = 0; ks < nks; ++ks) {
        const bf16x8 y = *(const GAS bf16x8*)(Wg + 32 * ks);
#pragma unroll
        for (int i = 0; i < 8; ++i) { const bf16x8 xf = *(const LAS bf16x8*)(vnT + (16 * i + fr) * VP + 32 * ks + 8 * fq);
            acc[i] = __builtin_amdgcn_mfma_f32_16x16x32_bf16(xf, y, acc[i], 0, 0, 0); }
    }
    const int t = 16 * wid + fr; const long tok = (long)b * SEQ + c * 128 + t;
    const float bs = A.in[14][g * 128 + t];
    const bf16* up = (const bf16*)(ws + WS_SU) + tok * 512 + g * 128 + 4 * fq;
    float sg[8][4]; float ss = 0.f;
#pragma unroll
    for (int i = 0; i < 8; ++i) { const u32x2_t uw = *(const GAS u32x2_t*)(up + 16 * i);
        sg[i][0] = bflo(uw.x) * (acc[i][0] + bs); sg[i][1] = bfhi(uw.x) * (acc[i][1] + bs); sg[i][2] = bflo(uw.y) * (acc[i][2] + bs); sg[i][3] = bfhi(uw.y) * (acc[i][3] + bs);
        ss += (sg[i][0] * sg[i][0] + sg[i][1] * sg[i][1]) + (sg[i][2] * sg[i][2] + sg[i][3] * sg[i][3]); }
    ss += sxor<16>(ss); ss = sum32(ss);
    const float rn = 1.0f / sqrtf(ss * (1.0f / 128.0f) + RMS_EPS);
    bf16* mp = (bf16*)(ws + WS_MIX) + tok * 1024 + 512 + g * 128 + 4 * fq;
    const float* og = A.in[15] + g * 128 + 4 * fq;
#pragma unroll
    for (int i = 0; i < 8; ++i) { const f32x4 gv = *(const GAS f32x4*)(og + 16 * i);
        *(GAS u32x2_t*)(mp + 16 * i) = (u32x2_t){cvtpk(sg[i][0] * rn * gv.x, sg[i][1] * rn * gv.y), cvtpk(sg[i][2] * rn * gv.z, sg[i][3] * rn * gv.w)}; }
    __syncthreads();
}
__device__ __forceinline__ void p2_mixers(Frame& F, const Args& A) {
    unsigned char* ws = F.ws;
    const int l0 = otid() & 63;
    const float lam = __builtin_bit_cast(float, __builtin_amdgcn_readfirstlane(__builtin_bit_cast(int, expf(wave_sum(A.in[6][l0] * A.in[7][l0])) - expf(wave_sum(A.in[8][l0] * A.in[9][l0])) + LAMBDA_INIT)));
    const attn_body::bf16* Q = (const attn_body::bf16*)(ws + WS_Q); const attn_body::bf16* Kt = (const attn_body::bf16*)(ws + WS_K); const attn_body::bf16* V = (const attn_body::bf16*)(ws + WS_V);
    attn_body::bf16* Oraw = (attn_body::bf16*)(ws + WS_HB);
    for (int it = F.vcu; it < 256; it += F.G) {
        const int bh = it >> 2, s = it & 3, b = bh >> 2, h = bh & 3;
        for (int j = 0; j < 8; ++j) {
            const int qb = (j < 4) ? 7 - s : s, sp = j & 3, m = sp >> 1, vh = sp & 1;
            attn_body::attn_unit<8>(F.wave, (long)b * SEQ, qb, Q + (h * 2 + m) * 64, Kt + (h * 2 + m) * 64, V + h * 128 + vh * 64, Oraw + ((h * 2 + m) * 2 + vh) * 64, (char*)(F.lds + RING_OFF));
            if (sp == 3) attn_combine((long)b * SEQ + qb * 256 + F.wave * 32, h, (const bf16*)(ws + WS_HB), (bf16*)(ws + WS_MIX), A.in[10], lam);
        }
    }
    for (int u = F.vcu; u < BATCH * 16 * 4; u += F.G) sgu_unit(F, A, u >> 6, (u >> 2) & 15, u & 3);
}

__device__ __forceinline__ void p4_router(Frame& F, const Args& A) {
    unsigned char* ws = F.ws;
    const int tid = otid(), lane = tid & 63, wid = F.wave, fr = lane & 15, fq = lane >> 4;
    LAS float* lg = (LAS float*)(F.lds + RING_OFF) + wid * (16 * 49);
    LAS unsigned* hist = (LAS unsigned*)(F.lds + L_HIST); LAS unsigned* base = (LAS unsigned*)(F.lds + L_BASE);
    const bf16* HB = (const bf16*)(ws + WS_HB); const bf16* WR = (const bf16*)(ws + WS_WR);
    const float* hst = (const float*)(ws + WS_HST); float* rstd2 = (float*)(ws + WS_RSTD2);
    int* elist = (int*)(ws + WS_ELIST); float* pgate = (float*)(ws + WS_PGATE);
    for (int blk = F.vcu; blk < T / 128; blk += F.G) {
        if (tid < 32) hist[tid] = 0u;
        __syncthreads();
        const int tok0 = blk * 128 + wid * 16;
        f32x4 acc[3];
#pragma unroll
        for (int n = 0; n < 3; ++n) acc[n] = (f32x4){0.f, 0.f, 0.f, 0.f};
        const bf16* hp = HB + (size_t)(tok0 + fr) * 1024 + 8 * fq; const bf16* wp = WR + fr * 1024 + 8 * fq;
#pragma unroll 4
        for (int ks = 0; ks < 32; ++ks) {
            const bf16x8 y = *(const GAS bf16x8*)(hp + 32 * ks);
#pragma unroll
            for (int n = 0; n < 3; ++n) { const bf16x8 xf = *(const GAS bf16x8*)(wp + n * 16 * 1024 + 32 * ks); acc[n] = __builtin_amdgcn_mfma_f32_16x16x32_bf16(xf, y, acc[n], 0, 0, 0); }
        }
        float rs; { const float* hs = hst + (size_t)(tok0 + fr) * 16; float s = 0.f;
#pragma unroll
            for (int i = 0; i < 4; ++i) { const f32x4 p = *(const GAS f32x4*)(hs + 4 * i); s += (p.x + p.y) + (p.z + p.w); }
            rs = 1.0f / sqrtf(s * (1.0f / 1024.0f) + RMS_EPS); if (fq == 0) rstd2[tok0 + fr] = rs; }
#pragma unroll
        for (int n = 0; n < 3; ++n)
#pragma unroll
            for (int r = 0; r < 4; ++r) { const int j = 16 * n + 4 * fq + r; float bias = 0.f; if (j < 32) bias = A.in[21][j]; else if (j < 36) bias = A.in[19][j - 32];
                lg[fr * 49 + j] = acc[n][r] * rs + bias; }
        LDS_WAIT(); asm volatile("" ::: "memory");
        int e1 = 0, e2 = 0; unsigned l1 = 0, l2 = 0; float g1 = 0.f, g2 = 0.f;
        if (lane < 16) {
            const LAS float* L = lg + lane * 49;
            float gm = L[32]; int grp = 0;
#pragma unroll
            for (int i = 1; i < 4; ++i) { const float v = L[32 + i]; if (v > gm) { gm = v; grp = i; } }
            float Z = 0.f;
#pragma unroll
            for (int i = 0; i < 4; ++i) Z += expf(L[32 + i] - gm);
            const float pg = 1.0f / Z;
            float el[8];
#pragma unroll
            for (int i = 0; i < 8; ++i) el[i] = L[grp * 8 + i];
            float v1 = el[0]; int i1 = 0;
#pragma unroll
            for (int i = 1; i < 8; ++i) if (el[i] > v1) { v1 = el[i]; i1 = i; }
            float v2 = -INFINITY; int i2 = 0;
#pragma unroll
            for (int i = 0; i < 8; ++i) if (i != i1 && el[i] > v2) { v2 = el[i]; i2 = i; }
            const float s1 = 1.0f / (1.0f + expf(v2 - v1));
            g1 = pg * s1; g2 = pg * (1.0f - s1); e1 = grp * 8 + i1; e2 = grp * 8 + i2;
            l1 = __hip_atomic_fetch_add(&hist[e1], 1u, __ATOMIC_RELAXED, __HIP_MEMORY_SCOPE_WORKGROUP); l2 = __hip_atomic_fetch_add(&hist[e2], 1u, __ATOMIC_RELAXED, __HIP_MEMORY_SCOPE_WORKGROUP);
        }
        __syncthreads();
        if (tid < 32) base[tid] = __hip_atomic_fetch_add((unsigned*)(F.ctl + CW_CNT + 64 * tid), hist[tid], __ATOMIC_RELAXED, __HIP_MEMORY_SCOPE_AGENT);
        __syncthreads();
        if (lane < 16) { const int tok = tok0 + lane;
            elist[(size_t)e1 * ECAP + base[e1] + l1] = 2 * tok; pgate[2 * tok] = g1;
            elist[(size_t)e2 * ECAP + base[e2] + l2] = 2 * tok + 1; pgate[2 * tok + 1] = g2; }
        __syncthreads();
    }
}

__device__ __forceinline__ void moe_tables(Frame& F) {
    LAS int* ts = (LAS int*)(F.lds + L_TSTART); LAS int* rs = (LAS int*)(F.lds + L_RSTART); LAS int* cn = (LAS int*)(F.lds + L_CNT);
    const int tid = otid();
    if (tid < 32) cn[tid] = (int)__hip_atomic_load((unsigned*)(F.ctl + CW_CNT + 64 * tid), __ATOMIC_RELAXED, __HIP_MEMORY_SCOPE_AGENT);
    __syncthreads();
    if (tid == 0) { int a = 0, b = 0; for (int e = 0; e < NE; ++e) { ts[e] = a; rs[e] = b; a += (cn[e] + 255) >> 8; b += cn[e]; } ts[NE] = a; rs[NE] = b; }
    __syncthreads();
}
struct MoeOrder {
    const LAS int* ts; const LAS int* rs; const LAS int* cn; const int* elist; int G, c;
    __device__ __forceinline__ bool next(int i, pg8::Unit& u) const {
        const int L = i * G + c, total = ts[NE] * 4; if (L >= total) return false;
        const int rtg = L >> 2, ct = L & 3; int e = 0;
        for (int k = 1; k < NE; ++k) if (rtg >= ts[k]) e = k;
        const int rt = rtg - ts[e];
        u.e = e; u.pm = rt; u.pn = ct; u.nvalid = min(256, cn[e] - rt * 256); u.lst = elist + (size_t)e * ECAP + rt * 256;
        u.arow = rs[e] + rt * 256; u.brow = e * 1024 + ct * 256; return true;
    }
};

__device__ __forceinline__ void p7_combine(Frame& F) {
    const int gw = F.vcu * NWAVES + F.wave, NGW = F.G * NWAVES, lane = otid() & 63;
    const bf16* Y = (const bf16*)(F.ws + WS_Y);
    for (int m = gw; m < T; m += NGW) {
        GAS f32x4* o = (GAS f32x4*)(F.out + (size_t)m * D) + lane;
        const GAS u32x2_t* y0 = (const GAS u32x2_t*)(Y + (size_t)(2 * m) * D) + lane; const GAS u32x2_t* y1 = (const GAS u32x2_t*)(Y + (size_t)(2 * m + 1) * D) + lane;
#pragma unroll
        for (int j = 0; j < 4; ++j) { f32x4 h = o[64 * j]; const u32x2_t a = y0[64 * j], b = y1[64 * j];
            h.x += bflo(a.x) + bflo(b.x); h.y += bfhi(a.x) + bfhi(b.x); h.z += bflo(a.y) + bflo(b.y); h.w += bfhi(a.y) + bfhi(b.y); o[64 * j] = h; }
    }
}

__global__ void __launch_bounds__(NWAVES * 64, 2) hymba_fwd(Args args) {
    extern __shared__ __attribute__((aligned(16))) unsigned char lds[];
    Frame F;
    F.lds = (LAS unsigned char*)lds;
    F.wave = __builtin_amdgcn_readfirstlane((int)threadIdx.x >> 6);
    F.G = gridDim.x; { const int bx = blockIdx.x; F.vcu = (F.G % 8 == 0) ? (bx % 8) * (F.G / 8) + bx / 8 : bx; }
    unsigned char* ws = args.ws; F.ws = ws; F.out = args.out;
    F.ctl = (gu32*)(ws + WS_CTL);
    for (int u = threadIdx.x; u < (LDS_BYTES - LCTL_OFF) / 4; u += NWAVES * 64) ((LAS unsigned*)(F.lds + LCTL_OFF))[u] = 0u;
    __syncthreads();
    XcdBarrier bar; bar.bar = (unsigned*)(F.ctl + CW_BAR); bar.x = 0; bar.st = nullptr;
    if (N_LAUNCHES == 1) bar = xcd_barrier_post((unsigned*)(F.ctl + CW_BAR), (volatile LAS unsigned*)(F.lds + L_MISC), threadIdx.x == 0);
    const int lo = args.ph_lo, hi = args.ph_hi;
#define IN(k) (lo <= (k) && (k) < hi)
#define SEAM(k) do { if (IN(k) && IN((k) + 1)) xcd_barrier(bar, F.wave == 0 && olane() == 0); } while (0)

    if (IN(0)) { p0_prologue(F, args); } SEAM(0);
    if (IN(1)) {
        pg8::Gemm g{(const pg8::bf16_t*)(ws + WS_XB), (const pg8::bf16_t*)(ws + WS_WIN), D};
        pg8::StaticOrder S; S.init(T, INC, F.G, (int)blockIdx.x);
        pg8::EpiInProj E{(pg8::bf16_t*)(ws + WS_Q), (pg8::bf16_t*)(ws + WS_K), (pg8::bf16_t*)(ws + WS_V), (pg8::bf16_t*)(ws + WS_SU), (pg8::bf16_t*)(ws + WS_SV),
                         (const float*)(ws + WS_RSTD1), (const float*)(ws + WS_ROPE), args.in[4], args.in[5], (float*)(ws + WS_SVST)};
        pg8::gemm_phase<pg8::EpiInProj, pg8::StaticOrder, false>(F.lds + RING_OFF, g, S, E, F.wave);
    } SEAM(1);
    if (IN(2)) { p2_mixers(F, args); } SEAM(2);
    if (IN(3)) {
        pg8::Gemm g{(const pg8::bf16_t*)(ws + WS_MIX), (const pg8::bf16_t*)(ws + WS_WOUT), D};
        pg8::StaticOrder S; S.init(T, D, F.G, (int)blockIdx.x);
        pg8::EpiOutProj E{args.in[0], F.out, (pg8::bf16_t*)(ws + WS_HB), (float*)(ws + WS_HST)};
        pg8::gemm_phase<pg8::EpiOutProj, pg8::StaticOrder, false>(F.lds + RING_OFF, g, S, E, F.wave);
    } SEAM(3);
    if (IN(4)) { p4_router(F, args); } SEAM(4);
    if (IN(5)) {
        moe_tables(F);
        pg8::Gemm g{(const pg8::bf16_t*)(ws + WS_HB), (const pg8::bf16_t*)(ws + WS_W1), D};
        MoeOrder S{(const LAS int*)(F.lds + L_TSTART), (const LAS int*)(F.lds + L_RSTART), (const LAS int*)(F.lds + L_CNT), (const int*)(ws + WS_ELIST), F.G, (int)blockIdx.x};
        pg8::EpiMoeUp E{(pg8::bf16_t*)(ws + WS_XB), (const float*)(ws + WS_RSTD2), (const float*)(ws + WS_PGATE)};
        pg8::gemm_phase<pg8::EpiMoeUp, MoeOrder, true>(F.lds + RING_OFF, g, S, E, F.wave);
    } SEAM(5);
    if (IN(6)) {
        moe_tables(F);
        pg8::Gemm g{(const pg8::bf16_t*)(ws + WS_XB), (const pg8::bf16_t*)(ws + WS_W2), FF};
        MoeOrder S{(const LAS int*)(F.lds + L_TSTART), (const LAS int*)(F.lds + L_RSTART), (const LAS int*)(F.lds + L_CNT), (const int*)(ws + WS_ELIST), F.G, (int)blockIdx.x};
        pg8::EpiMoeDown E{(pg8::bf16_t*)(ws + WS_Y)};
        pg8::gemm_phase<pg8::EpiMoeDown, MoeOrder, false>(F.lds + RING_OFF, g, S, E, F.wave);
    } SEAM(6);
    if (IN(7)) { p7_combine(F); }
#undef IN
#undef SEAM
}

extern "C" void kernel_launch(void* const* d_in, const int* in_sizes, int n_in, void* d_out, int out_size, void* d_ws, size_t ws_size, hipStream_t stream) {
    static int grid = 0;
    if (grid == 0) {
        if (n_in != 25 || in_sizes[0] != T * D || out_size != T * D || ws_size < WS_END) { fprintf(stderr, "kernel_launch: shape/workspace mismatch (n_in %d, in0 %d, out %d, ws %zu); nothing launched\n", n_in, n_in > 0 ? in_sizes[0] : -1, out_size, ws_size); grid = -1; return; }
        int dev = 0, cus = 0, per_cu = 0;
        if (hipGetDevice(&dev) != hipSuccess || hipDeviceGetAttribute(&cus, hipDeviceAttributeMultiprocessorCount, dev) != hipSuccess) { grid = -1; return; }
        if (hipFuncSetAttribute((const void*)hymba_fwd, hipFuncAttributeMaxDynamicSharedMemorySize, LDS_BYTES) != hipSuccess) { fprintf(stderr, "kernel_launch: hipFuncSetAttribute failed\n"); grid = -1; return; }
        if (hipOccupancyMaxActiveBlocksPerMultiprocessor(&per_cu, (const void*)hymba_fwd, NWAVES * 64, LDS_BYTES) != hipSuccess || per_cu < 1) { fprintf(stderr, "kernel_launch: occupancy query reports %d workgroups per CU\n", per_cu); }
        (void)hipGetLastError();
        grid = cus;
        if (grid > 256) grid = 256;
    }
    if (grid < 0) return;
    if (hipMemsetAsync((char*)d_ws + WS_CTL, 0, CTL_ZERO_BYTES, stream) != hipSuccess) return;
    Args a{};
    for (int i = 0; i < 25; ++i) a.in[i] = (const float*)d_in[i];
    a.out = (float*)d_out; a.ws = (unsigned char*)d_ws;
    for (int i = 0; i < 8; ++i) a.ifq.f[i] = powf(500000.0f, -(float)(2 * i) / 16.0f);
    for (int li = 0; li < N_LAUNCHES; ++li) {
        a.ph_lo = (N_LAUNCHES == 1) ? 0 : li; a.ph_hi = (N_LAUNCHES == 1) ? NPH : li + 1;
        hipLaunchKernelGGL(hymba_fwd, dim3(grid), dim3(NWAVES * 64), LDS_BYTES, stream, a);
    }
}
```

```cpp
#include <hip/hip_runtime.h>
#include <hip/hip_bf16.h>
#include <cstdio>
#include <cstdint>
#include <cmath>
namespace pg8 {
#define PG8_LAS __attribute__((address_space(3)))
typedef unsigned short bf16_t;
typedef short bf16x8 __attribute__((ext_vector_type(8)));
typedef float f32x4 __attribute__((ext_vector_type(4)));
typedef unsigned u32x4 __attribute__((ext_vector_type(4)));
typedef unsigned u32x2 __attribute__((ext_vector_type(2)));
constexpr int BM = 256, BK = 64, HALF = 128, HTB = HALF * BK * 2  , STAGE_BYTES = 8 * HTB, NXCD = 8, WGM = 8;

__host__ __device__ __forceinline__ int lds_byte(int r, int c) { const int st = (r >> 4) * 2 + (c >> 5), rr = r & 15, cc = c & 31, ob = rr * 64 + cc * 2; return st * 1024 + (ob ^ (((ob >> 9) & 1) << 5)); }
__host__ __device__ __forceinline__ void stage_rc(int b, int& R, int& C) { const int st = b / 1024, sb = b % 1024, swz = sb ^ (((sb >> 9) & 1) << 5); R = (st >> 1) * 16 + swz / 64; C = (st & 1) * 32 + (swz % 64) / 2; }
__host__ __device__ __forceinline__ int perm32(int rho) { const int n = rho >> 4, i = rho & 15; return 8 * (i >> 2) + 4 * n + (i & 3); }

struct Unit { int arow, brow, pm, pn, e, nvalid; const int* lst; const float* vals; };
struct Gemm { const bf16_t* A; const bf16_t* Bt; int K; };

__device__ __forceinline__ unsigned cvt_pk_bf16(float lo, float hi) { unsigned r; asm volatile("v_cvt_pk_bf16_f32 %0, %1, %2" : "=v"(r) : "v"(lo), "v"(hi)); return r; }
#ifndef WT_STORES
#define WT_STORES 0
#endif
__device__ __forceinline__ void st16_wt(void* p, u32x4 v) {
#if WT_STORES == 1
    asm volatile("global_store_dwordx4 %0, %1, off sc1\n\ts_nop 1" :: "v"(p), "v"(v) : "memory");
#elif WT_STORES == 2
    __builtin_nontemporal_store(v, (u32x4*)p);
#else
    *(u32x4*)p = v;
#endif
}
__device__ __forceinline__ float bf_lo(unsigned w) { return __uint_as_float(w << 16); }
__device__ __forceinline__ float bf_hi(unsigned w) { return __uint_as_float(w & 0xffff0000u); }
typedef float f32x2 __attribute__((ext_vector_type(2)));
__device__ __forceinline__ f32x2 gelu_pk(f32x2 v) {
    const f32x2 av = __builtin_elementwise_abs(v), d = av * 0.2316418882f + 1.0f;
    f32x2 t; t.x = __builtin_amdgcn_rcpf(d.x); t.y = __builtin_amdgcn_rcpf(d.y);
    f32x2 q = t * 0.5307027145f + (-0.7265760135f); q = q * t + 0.7107068705f; q = q * t + (-0.142248368f); q = q * t + 0.127414796f; q = q * t;
    const f32x2 s = (v * v) * (-0.72134752044f);
    f32x2 e; e.x = __builtin_amdgcn_exp2f(s.x); e.y = __builtin_amdgcn_exp2f(s.y);
    const f32x2 m = v * (q * e), r = v - m;
    f32x2 o; o.x = v.x < 0.f ? m.x : r.x; o.y = v.y < 0.f ? m.y : r.y; return o;
}

struct StaticOrder {
    int nM, nN, nwg, G, c;
    __device__ void init(int M, int N, int G_, int c_) { nM = M / BM; nN = N / BM; nwg = nM * nN; G = G_; c = c_; }
    __device__ bool next(int i, Unit& u) const {
        const long L = (long)i * G + c; if (L >= nwg) return false;
        int wgid = (int)L; { const int q = nwg / NXCD, r = nwg % NXCD, xcd = wgid % NXCD, off = wgid / NXCD; wgid = (xcd < r ? xcd * (q + 1) : r * (q + 1) + (xcd - r) * q) + off; }
        const int nig = WGM * nN, gid = wgid / nig, fm = gid * WGM, gsz = (nM - fm) < WGM ? (nM - fm) : WGM;
        u.pm = fm + ((wgid % nig) % gsz); u.pn = (wgid % nig) / gsz; u.arow = u.pm * BM; u.brow = u.pn * BM; u.e = 0; u.nvalid = BM; u.lst = nullptr; u.vals = nullptr; return true;
    }
    static constexpr bool ROWREC = false;
};

typedef int v8i32 __attribute__((ext_vector_type(8)));
typedef int v4i32 __attribute__((ext_vector_type(4)));
__device__ __forceinline__ v8i32 cat8(bf16x8 lo, bf16x8 hi) { const v4i32 a = __builtin_bit_cast(v4i32, lo), b = __builtin_bit_cast(v4i32, hi); return __builtin_shufflevector(a, b, 0, 1, 2, 3, 4, 5, 6, 7); }
__device__ __forceinline__ void mfma8(f32x4& c, const v8i32& a, const v8i32& b, const int sc) {
    asm volatile("v_mfma_scale_f32_16x16x128_f8f6f4 %0, %1, %2, %0, %3, %3 op_sel_hi:[0,0,0]" : "+v"(c) : "v"(a), "v"(b), "v"(sc)); }
template <class Epi, class Sched, bool GATHER, bool FP8 = false>
__device__ __forceinline__ void gemm_phase(PG8_LAS unsigned char* lds, const Gemm g, const Sched& S, const Epi& E, const int wid  ) {
    int lane; asm volatile("v_mbcnt_lo_u32_b32 %0, -1, 0\n\tv_mbcnt_hi_u32_b32 %0, -1, %0" : "=v"(lane));
    const int tid = wid * 64 + lane, wr = wid >> 2, wc = wid & 3, fr = lane & 15, fq = lane >> 4;
    const int K = g.K, nt = K / BK;
    unsigned voffA[2], voffB[2]; int RA[2], CA[2];
#pragma unroll
    for (int i = 0; i < 2; ++i) { int R, C; stage_rc(tid * 16 + i * 8192, R, C); const int Rb = (R & ~31) + perm32(R & 31);
        voffA[i] = (unsigned)(R * K + C) * 2u; voffB[i] = (unsigned)(Rb * K + C) * 2u; RA[i] = R; CA[i] = C * 2; }
    const size_t kstep = (size_t)(BK * 2);
    const size_t hstep = (size_t)HALF * K * 2;
    const unsigned ldsw = (unsigned)wid * 1024u;
    const int aoff = lds_byte(wr * 64 + fr, fq * 8), boff = lds_byte(wc * 32 + fr, fq * 8);
#define PG8_SA(b, h) (((b) * 2 + (h)) * HTB)
#define PG8_SB(b, h) ((4 + (b) * 2 + (h)) * HTB)
#define PG8_STAGE(bufoff, gbase, voff) do { _Pragma("unroll") for (int _i = 0; _i < 2; ++_i) \
        __builtin_amdgcn_global_load_lds((const unsigned*)((const char*)(gbase) + (voff)[_i]), (PG8_LAS unsigned*)(lds + (bufoff) + ldsw + _i * 8192), 16, 0, 0); } while (0)
#define PG8_STAGE_A(bufoff, kofs, h, nx) do { if constexpr (GATHER) { unsigned _o[2]; _o[0] = (nx) ? gN[h][0] : gC[h][0]; _o[1] = (nx) ? gN[h][1] : gC[h][1]; PG8_STAGE(bufoff, (const char*)g.A + (kofs), _o); } \
        else { PG8_STAGE(bufoff, ((nx) ? nA : cA) + (size_t)(h) * hstep + (kofs), voffA); } } while (0)
#define PG8_LDA(dst, b, h) do { if constexpr (FP8) { _Pragma("unroll") for (int m = 0; m < 4; ++m) dst##8[m] = cat8(*(const PG8_LAS bf16x8*)(lds + PG8_SA(b, h) + aoff + m * 2048), *(const PG8_LAS bf16x8*)(lds + PG8_SA(b, h) + aoff + m * 2048 + 1024)); } \
        else { _Pragma("unroll") for (int m = 0; m < 4; ++m) _Pragma("unroll") for (int k = 0; k < 2; ++k) dst[m][k] = *(const PG8_LAS bf16x8*)(lds + PG8_SA(b, h) + aoff + m * 2048 + k * 1024); } } while (0)
#define PG8_LDB(dst, b, h) do { if constexpr (FP8) { _Pragma("unroll") for (int n = 0; n < 2; ++n) dst##8[n] = cat8(*(const PG8_LAS bf16x8*)(lds + PG8_SB(b, h) + boff + n * 2048), *(const PG8_LAS bf16x8*)(lds + PG8_SB(b, h) + boff + n * 2048 + 1024)); } \
        else { _Pragma("unroll") for (int n = 0; n < 2; ++n) _Pragma("unroll") for (int k = 0; k < 2; ++k) dst[n][k] = *(const PG8_LAS bf16x8*)(lds + PG8_SB(b, h) + boff + n * 2048 + k * 1024); } } while (0)
#define PG8_MMA(ai, bj, At, Bt) do { __builtin_amdgcn_s_setprio(1); if constexpr (FP8) { _Pragma("unroll") for (int m = 0; m < 4; ++m) _Pragma("unroll") for (int n = 0; n < 2; ++n) \
        mfma8(acc[ai][bj][m][n], Bt##8[n], At##8[m], sc1); } else { \
        _Pragma("unroll") for (int m = 0; m < 4; ++m) _Pragma("unroll") for (int n = 0; n < 2; ++n) _Pragma("unroll") for (int k = 0; k < 2; ++k) \
        acc[ai][bj][m][n] = __builtin_amdgcn_mfma_f32_16x16x32_bf16(Bt[n][k], At[m][k], acc[ai][bj][m][n], 0, 0, 0); } __builtin_amdgcn_s_setprio(0); } while (0)
#define PG8_WAIT_V(n) asm volatile("s_waitcnt vmcnt(" #n ")" ::: "memory")
#define PG8_WAIT_L(n) asm volatile("s_waitcnt lgkmcnt(" #n ")" ::: "memory")
#define PG8_BAR __builtin_amdgcn_s_barrier()
#define PG8_SCHED __builtin_amdgcn_sched_barrier(0)
#define PG8_GOFF(G_, U) do { _Pragma("unroll") for (int _h = 0; _h < 2; ++_h) _Pragma("unroll") for (int _i = 0; _i < 2; ++_i) { int _ix = _h * HALF + RA[_i]; _ix = _ix < (U).nvalid ? _ix : (U).nvalid - 1; \
        const int _p = (U).lst[_ix]; G_[_h][_i] = (unsigned)(_p >> 1) * (unsigned)(K * 2) + (unsigned)CA[_i]; } } while (0)
    Unit cur, nxt; int ui = 0;
    if (!S.next(0, cur)) return;
    f32x4 acc[2][2][4][2];
#pragma unroll
    for (int a = 0; a < 2; ++a)
#pragma unroll
        for (int b = 0; b < 2; ++b)
#pragma unroll
            for (int m = 0; m < 4; ++m)
#pragma unroll
                for (int n = 0; n < 2; ++n) acc[a][b][m][n] = (f32x4){0.f, 0.f, 0.f, 0.f};
    bf16x8 At[4][2], B0[2][2], B1[2][2]; v8i32 At8[4], B08[2], B18[2];
    int sc1 = 0x7f7f7f7f; asm volatile("" : "+v"(sc1));
    unsigned gC[2][2] = {{0u, 0u}, {0u, 0u}}, gN[2][2] = {{0u, 0u}, {0u, 0u}};
    if constexpr (GATHER) { PG8_GOFF(gC, cur); }
    const char* cA = (const char*)g.A + (size_t)cur.arow * K * 2; const char* cB = (const char*)g.Bt + (size_t)cur.brow * K * 2;
    const char* nA = cA; const char* nB = cB;
    PG8_STAGE(PG8_SB(0, 0), cB, voffB); PG8_STAGE(PG8_SB(0, 1), cB + hstep, voffB); PG8_STAGE_A(PG8_SA(0, 0), 0, 0, false); PG8_STAGE_A(PG8_SA(0, 1), 0, 1, false);
    if (wr == 1) PG8_BAR;
    PG8_WAIT_V(2); PG8_BAR;
    PG8_STAGE(PG8_SB(1, 0), cB + kstep, voffB); PG8_STAGE_A(PG8_SA(1, 0), kstep, 0, false); PG8_STAGE(PG8_SB(1, 1), cB + hstep + kstep, voffB);
    PG8_WAIT_V(6); PG8_BAR;
    for (;;) {
        const bool has_next = S.next(ui + 1, nxt);
        int rrp = 0; float rrv = 0.f;
        if constexpr (Sched::ROWREC) { if (wr == 0) { const int ix = tid < cur.nvalid ? tid : cur.nvalid - 1; rrp = cur.lst[ix]; rrv = cur.vals[2 * ix + Sched::VALSEL]; } }
        nA = has_next ? (const char*)g.A + (size_t)nxt.arow * K * 2 : cA; nB = has_next ? (const char*)g.Bt + (size_t)nxt.brow * K * 2 : cB;
        if constexpr (GATHER) { if (has_next) { PG8_GOFF(gN, nxt); } else { gN[0][0] = gC[0][0]; gN[0][1] = gC[0][1]; gN[1][0] = gC[1][0]; gN[1][1] = gC[1][1]; } }
#pragma clang loop unroll(disable)
        for (int t = 0; t < nt; t += 2) {
            const bool last = (t == nt - 2);
            const size_t k1 = (size_t)(t + 1) * kstep;
            const size_t k2 = last ? (size_t)0 : (size_t)(t + 2) * kstep;
            const char* b2 = last ? nB : cB + (size_t)(t + 2) * kstep;
            const size_t k3 = k2 + kstep; const char* b3 = b2 + kstep;
            PG8_LDB(B0, 0, 0); PG8_LDB(B1, 0, 1); PG8_SCHED; PG8_LDA(At, 0, 0); PG8_STAGE_A(PG8_SA(1, 1), k1, 1, false);
            PG8_WAIT_V(8); PG8_WAIT_L(0); PG8_BAR; PG8_MMA(0, 0, At, B0); PG8_MMA(0, 1, At, B1); PG8_BAR; PG8_SCHED;
            PG8_LDA(At, 0, 1); PG8_STAGE(PG8_SB(0, 0), b2, voffB); PG8_STAGE(PG8_SB(0, 1), b2 + hstep, voffB); PG8_STAGE_A(PG8_SA(0, 0), k2, 0, last);
            PG8_WAIT_V(8); PG8_WAIT_L(0); PG8_BAR; PG8_MMA(1, 0, At, B0); PG8_MMA(1, 1, At, B1); PG8_BAR; PG8_SCHED;
            PG8_LDB(B0, 1, 0); PG8_LDB(B1, 1, 1); PG8_SCHED; PG8_LDA(At, 1, 0); PG8_STAGE_A(PG8_SA(0, 1), k2, 1, last);
            PG8_WAIT_V(8); PG8_WAIT_L(0); PG8_BAR; PG8_MMA(0, 0, At, B0); PG8_MMA(0, 1, At, B1); PG8_BAR; PG8_SCHED;
            PG8_LDA(At, 1, 1); PG8_STAGE(PG8_SB(1, 0), b3, voffB); PG8_STAGE(PG8_SB(1, 1), b3 + hstep, voffB); PG8_STAGE_A(PG8_SA(1, 0), k3, 0, last);
            PG8_WAIT_V(8); PG8_WAIT_L(0); PG8_BAR; PG8_MMA(1, 0, At, B0); PG8_MMA(1, 1, At, B1); PG8_BAR; PG8_SCHED;
        }
        if constexpr (Sched::ROWREC) { if (wr == 0) { *(PG8_LAS u32x2*)(S.rowtab + tid * 8) = (u32x2){(unsigned)rrp, __float_as_uint(rrv)}; PG8_WAIT_L(0); } }
        if (wr == 0) PG8_BAR;
        if constexpr (FP8) asm volatile("s_nop 15\n\ts_nop 15" ::: "memory");
        E(acc, cur, wr, wc, fr, fq);
        if (!has_next) break;
#pragma unroll
        for (int a = 0; a < 2; ++a)
#pragma unroll
            for (int b = 0; b < 2; ++b)
#pragma unroll
                for (int m = 0; m < 4; ++m)
#pragma unroll
                    for (int n = 0; n < 2; ++n) acc[a][b][m][n] = (f32x4){0.f, 0.f, 0.f, 0.f};
        cur = nxt; cA = nA; cB = nB; ++ui;
        if constexpr (GATHER) { gC[0][0] = gN[0][0]; gC[0][1] = gN[0][1]; gC[1][0] = gN[1][0]; gC[1][1] = gN[1][1]; }
        if (wr == 1) PG8_BAR;
    }
    PG8_WAIT_V(0);
    PG8_BAR;
#undef PG8_SA
#undef PG8_SB
#undef PG8_STAGE
#undef PG8_STAGE_A
#undef PG8_LDA
#undef PG8_LDB
#undef PG8_MMA
#undef PG8_WAIT_V
#undef PG8_WAIT_L
#undef PG8_BAR
#undef PG8_SCHED
#undef PG8_GOFF
}
}
namespace pg8 {
template <int MASK> __device__ __forceinline__ float sxor(float v) { return __builtin_bit_cast(float, __builtin_amdgcn_ds_swizzle(__builtin_bit_cast(int, v), (MASK << 10) | 0x1f)); }
__device__ __forceinline__ float sum32(float v) { auto r = __builtin_amdgcn_permlane32_swap(__float_as_uint(v), __float_as_uint(v), false, false); return __uint_as_float(r[0]) + __uint_as_float(r[1]); }
constexpr float RMS_EPS = 1e-6f;
constexpr float H8_SCALE = 16.0f, W1_SCALE = 256.0f, ACT_SCALE = 8.0f, W2_SCALE = 128.0f, Y8_SCALE = 64.0f;
__device__ __forceinline__ float clamp8(float v) { return __builtin_fminf(__builtin_fmaxf(v, -448.0f), 448.0f); }
__device__ __forceinline__ unsigned pk4_fp8(float a, float b, float c, float d) { int w = 0; w = __builtin_amdgcn_cvt_pk_fp8_f32(clamp8(a), clamp8(b), w, false); w = __builtin_amdgcn_cvt_pk_fp8_f32(clamp8(c), clamp8(d), w, true); return (unsigned)w; }
constexpr float QSCALE_C2 = 0.125f * 1.4426950408889634f;

struct EpiInProj {
    bf16_t *q, *k, *v, *su, *sv; const float* rstd1; const float* rope; const float* qg; const float* kg; float* svst; int mode;
    __device__ __forceinline__ void operator()(const f32x4 (&acc)[2][2][4][2], const Unit& u, int wr, int wc, int fr, int fq) const {
        if (mode == 2) return;
        const int cls = u.pn >> 1, G = (u.pn & 1) * 4 + wc, colbase = G * 64 + 8 * fq;
        bf16_t* dst = cls == 0 ? q : cls == 1 ? k : cls == 2 ? v : cls == 3 ? su : sv;
        float gain[16];
        if (cls < 2) { const float* gp = (cls == 0 ? qg : kg) + 8 * fq;
#pragma unroll
            for (int i = 0; i < 8; ++i) { gain[i] = gp[i]; gain[8 + i] = gp[32 + i]; } }
#pragma unroll
        for (int ai = 0; ai < 2; ++ai)
#pragma unroll
            for (int m = 0; m < 4; ++m) {
                const int row = u.pm * BM + ai * HALF + wr * 64 + m * 16 + fr;
                const float rs = rstd1[row];
                float x[16];
#pragma unroll
                for (int bj = 0; bj < 2; ++bj)
#pragma unroll
                    for (int n = 0; n < 2; ++n)
#pragma unroll
                        for (int j = 0; j < 4; ++j) x[8 * bj + 4 * n + j] = acc[ai][bj][m][n][j] * rs;
                if (cls < 2) {
                    float ss = 0.f;
#pragma unroll
                    for (int i = 0; i < 16; ++i) ss += x[i] * x[i];
                    ss += sxor<16>(ss); ss = sum32(ss);
                    const float rn = __builtin_amdgcn_rsqf(ss * (1.0f / 64.0f) + RMS_EPS);
#pragma unroll
                    for (int i = 0; i < 16; ++i) x[i] = x[i] * rn * gain[i];
                    float oth[8];
#pragma unroll
                    for (int i = 0; i < 8; ++i) oth[i] = sxor<16>(x[i]);
                    if (fq < 2) {
                        const f32x4 c0 = *(const f32x4*)(rope + (size_t)row * 16), c1 = *(const f32x4*)(rope + (size_t)row * 16 + 4);
                        const f32x4 s0 = *(const f32x4*)(rope + (size_t)row * 16 + 8), s1 = *(const f32x4*)(rope + (size_t)row * 16 + 12);
#pragma unroll
                        for (int i = 0; i < 8; ++i) { const float c = i < 4 ? c0[i & 3] : c1[i & 3], s = i < 4 ? s0[i & 3] : s1[i & 3];
                            x[i] = fq == 0 ? x[i] * c - oth[i] * s : oth[i] * s + x[i] * c; }
                    }
                    if (cls == 0) {
#pragma unroll
                        for (int i = 0; i < 16; ++i) x[i] *= QSCALE_C2; }
                } else if (cls == 4) {
#pragma unroll
                    for (int i = 0; i < 16; i += 2) { const f32x2 gv = gelu_pk((f32x2){x[i], x[i + 1]}); x[i] = gv.x; x[i + 1] = gv.y; }
                    {
                        float s1 = 0.f, s2 = 0.f;
#pragma unroll
                        for (int i = 0; i < 16; ++i) { s1 += x[i]; s2 += x[i] * x[i]; }
                        s1 += sxor<16>(s1); s1 = sum32(s1); s2 += sxor<16>(s2); s2 = sum32(s2);
                        if (fq == 0) *(f32x2*)(svst + (size_t)row * 16 + G * 2) = (f32x2){s1, s2};
                    }
                }
                u32x4 w0, w1;
                w0.x = cvt_pk_bf16(x[0], x[1]); w0.y = cvt_pk_bf16(x[2], x[3]); w0.z = cvt_pk_bf16(x[4], x[5]); w0.w = cvt_pk_bf16(x[6], x[7]);
                w1.x = cvt_pk_bf16(x[8], x[9]); w1.y = cvt_pk_bf16(x[10], x[11]); w1.z = cvt_pk_bf16(x[12], x[13]); w1.w = cvt_pk_bf16(x[14], x[15]);
                bf16_t* rp = dst + (size_t)row * 512 + colbase;
                st16_wt(rp, w0); st16_wt(rp + 32, w1);
            }
    }
};

struct EpiOutProj {
    const bf16_t* xb; bf16_t* hb; float* hst;
    __device__ __forceinline__ void operator()(const f32x4 (&acc)[2][2][4][2], const Unit& u, int wr, int wc, int fr, int fq) const {
#pragma unroll
        for (int ai = 0; ai < 2; ++ai)
#pragma unroll
            for (int m = 0; m < 4; ++m) {
                const int row = u.pm * BM + ai * HALF + wr * 64 + m * 16 + fr;
                float ss = 0.f;
#pragma unroll
                for (int bj = 0; bj < 2; ++bj) {
                    const size_t off = (size_t)row * 1024 + u.pn * BM + bj * HALF + wc * 32 + 8 * fq;
                    const u32x4 xw = *(const u32x4*)(xb + off);
                    const f32x4 h0 = (f32x4){bf_lo(xw.x), bf_hi(xw.x), bf_lo(xw.y), bf_hi(xw.y)} + acc[ai][bj][m][0], h1 = (f32x4){bf_lo(xw.z), bf_hi(xw.z), bf_lo(xw.w), bf_hi(xw.w)} + acc[ai][bj][m][1];
                    u32x4 w; w.x = cvt_pk_bf16(h0[0], h0[1]); w.y = cvt_pk_bf16(h0[2], h0[3]); w.z = cvt_pk_bf16(h1[0], h1[1]); w.w = cvt_pk_bf16(h1[2], h1[3]);
                    st16_wt(hb + off, w);
                    ss += (h0[0] * h0[0] + h0[1] * h0[1]) + (h0[2] * h0[2] + h0[3] * h0[3]) + (h1[0] * h1[0] + h1[1] * h1[1]) + (h1[2] * h1[2] + h1[3] * h1[3]);
                }
                ss += sxor<16>(ss); ss = sum32(ss);
                if (fq == 0) hst[(size_t)row * 16 + u.pn * 4 + wc] = ss;
            }
    }
};

struct EpiMoeUp {
    unsigned char* act8; const PG8_LAS unsigned char* rowtab;
    __device__ __forceinline__ void operator()(const f32x4 (&acc)[2][2][4][2], const Unit& u, int wr, int wc, int fr, int fq) const {
#pragma unroll
        for (int ai = 0; ai < 2; ++ai)
#pragma unroll
            for (int m = 0; m < 4; ++m) {
                const int rl = ai * HALF + wr * 64 + m * 16 + fr;
                const bool valid = rl < u.nvalid;
                const float rs = __uint_as_float((*(const PG8_LAS u32x2*)(rowtab + rl * 8)).y) * (1.0f / (H8_SCALE * W1_SCALE));
                float a[8];
#pragma unroll
                for (int n = 0; n < 2; ++n)
#pragma unroll
                    for (int j = 0; j < 4; ++j) { const float gt = acc[ai][0][m][n][j] * rs, up = acc[ai][1][m][n][j] * rs;
                        const float sg = gt * __builtin_amdgcn_rcpf(1.0f + __builtin_amdgcn_exp2f(-1.4426950408889634f * gt));
                        a[4 * n + j] = sg * up * ACT_SCALE; }
                if (valid) *(u32x2*)(act8 + (size_t)(u.arow + rl) * 512 + u.pn * 128 + wc * 32 + 8 * fq) = (u32x2){pk4_fp8(a[0], a[1], a[2], a[3]), pk4_fp8(a[4], a[5], a[6], a[7])};
            }
    }
};

struct EpiMoeDown {
    unsigned char* y8; const PG8_LAS unsigned char* rowtab; int mode;
    __device__ __forceinline__ void operator()(const f32x4 (&acc)[2][2][4][2], const Unit& u, int wr, int wc, int fr, int fq) const {
        if (mode == 2) return;
#pragma unroll
        for (int ai = 0; ai < 2; ++ai)
#pragma unroll
            for (int m = 0; m < 4; ++m) {
                const int rl = ai * HALF + wr * 64 + m * 16 + fr;
                const bool valid = (rl < u.nvalid) && (mode == 0);
                const u32x2 rec = *(const PG8_LAS u32x2*)(rowtab + rl * 8); const int p = (int)rec.x;
                const float gw = __uint_as_float(rec.y) * (Y8_SCALE / (ACT_SCALE * W2_SCALE));
                const f32x4 a0 = acc[ai][0][m][0] * gw, a1 = acc[ai][0][m][1] * gw, b0 = acc[ai][1][m][0] * gw, b1 = acc[ai][1][m][1] * gw;
                const u32x4 w = (u32x4){pk4_fp8(a0[0], a0[1], a0[2], a0[3]), pk4_fp8(a1[0], a1[1], a1[2], a1[3]), pk4_fp8(b0[0], b0[1], b0[2], b0[3]), pk4_fp8(b1[0], b1[1], b1[2], b1[3])};
                if (valid) *(u32x4*)(y8 + (size_t)p * 1024 + u.pn * BM + wc * 64 + 16 * fq) = w; else asm volatile("" :: "v"(w));
            }
    }
};
}
#include <hip/hip_bf16.h>
#include <cmath>
namespace attn_body {
using bf16=__hip_bfloat16;
using bf16x8=__attribute__((ext_vector_type(8)))short;
using s16x4=__attribute__((ext_vector_type(4)))short;
using f32x16=__attribute__((ext_vector_type(16)))float;
using u32x4=__attribute__((ext_vector_type(4)))unsigned;
constexpr int SEQ=2048,D=64,QP=512,KP=512,VP=512,OP=1024;
constexpr int NW=8,QBLK=32,QB=QBLK*NW,KVBLK=64,NQB=SEQ/QB;
constexpr int ATTN_UNIT_ROWS=QB;
__device__ __forceinline__ int crow(int r,int hi){return (r&3)+8*(r>>2)+4*hi;}
#define SBAR() __builtin_amdgcn_sched_barrier(0)
__device__ __forceinline__ void cmask(f32x16&p0,f32x16&p1,int jb,int qrel,int hi){
  const float NEG=-INFINITY; int kb=64*jb+4*hi;
  #pragma unroll
  for(int r=0;r<16;++r){int kv=kb+(r&3)+8*(r>>2); if(kv>qrel)p0[r]=NEG; if(kv+32>qrel)p1[r]=NEG;}
}

constexpr int NSLOT=3, SLOTB=8192;
constexpr int LDS_K=0, LDS_V=NSLOT*SLOTB, LDS_WS=2*NSLOT*SLOTB, LDS_OST=LDS_WS+NW*64*4, LDS_BYTES=LDS_OST+NW*4096;
constexpr float C2=0.125f*1.4426950408889634f;
__device__ __forceinline__ void glds16(const void*gsrc,unsigned lds_dst){unsigned keep;
  asm volatile("s_mov_b32 %0, m0\n\ts_mov_b32 m0, %2\n\ts_nop 0\n\tglobal_load_lds_dwordx4 %1, off\n\ts_mov_b32 m0, %0":"=&s"(keep):"v"(gsrc),"s"(lds_dst):"memory");}
__device__ __forceinline__ float max3f(float a,float b,float c){float r;asm("v_max3_f32 %0, %1, %2, %3":"=v"(r):"v"(a),"v"(b),"v"(c));return r;}
__device__ __forceinline__ float max2f(float a,float b){float r;asm("v_max_f32_e32 %0, %1, %2":"=v"(r):"v"(a),"v"(b));return r;}
__device__ __forceinline__ float fadd_s(float a,float b){float r;asm("v_add_f32_e32 %0, %1, %2":"=v"(r):"v"(a),"v"(b));return r;}
__device__ __forceinline__ float fsub_s(float a,float b){float r;asm("v_sub_f32_e32 %0, %1, %2":"=v"(r):"v"(a),"v"(b));return r;}
typedef float f32x2_t __attribute__((ext_vector_type(2))); typedef __bf16 bf16x2_t __attribute__((ext_vector_type(2)));
__device__ __forceinline__ unsigned cvtpk_s(float lo,float hi){f32x2_t v={lo,hi};bf16x2_t b=__builtin_convertvector(v,bf16x2_t);return __builtin_bit_cast(unsigned,b);}
#define WAIT_BAR(N) asm volatile("s_waitcnt vmcnt(" #N ") lgkmcnt(0)\n\ts_barrier":::"memory")

__device__ __forceinline__ void qkt(f32x16&p0,f32x16&p1,const char*Kslot,const bf16x8*qr,const f32x16&negm,int r32,int hi){
  const char*kb=Kslot+hi*1024+r32*16;
  #pragma unroll
  for(int d0=0;d0<4;++d0){
    const bf16x8 b0=*reinterpret_cast<const bf16x8*>(kb+d0*2048);
    const bf16x8 b1=*reinterpret_cast<const bf16x8*>(kb+d0*2048+512);
    if(d0==0){p0=__builtin_amdgcn_mfma_f32_32x32x16_bf16(b0,qr[0],negm,0,0,0);p1=__builtin_amdgcn_mfma_f32_32x32x16_bf16(b1,qr[0],negm,0,0,0);}
    else{p0=__builtin_amdgcn_mfma_f32_32x32x16_bf16(b0,qr[d0],p0,0,0,0);p1=__builtin_amdgcn_mfma_f32_32x32x16_bf16(b1,qr[d0],p1,0,0,0);}}
}
typedef __attribute__((address_space(3))) const char* lds_cptr;
typedef short v4i16_t __attribute__((ext_vector_type(4)));
__device__ __forceinline__ void kload8(bf16x8*kf,lds_cptr kp){
  kf[0]=*(const __attribute__((address_space(3))) bf16x8*)(kp);      kf[1]=*(const __attribute__((address_space(3))) bf16x8*)(kp+512);
  kf[2]=*(const __attribute__((address_space(3))) bf16x8*)(kp+2048); kf[3]=*(const __attribute__((address_space(3))) bf16x8*)(kp+2560);
  kf[4]=*(const __attribute__((address_space(3))) bf16x8*)(kp+4096); kf[5]=*(const __attribute__((address_space(3))) bf16x8*)(kp+4608);
  kf[6]=*(const __attribute__((address_space(3))) bf16x8*)(kp+6144); kf[7]=*(const __attribute__((address_space(3))) bf16x8*)(kp+6656);
}
__device__ __forceinline__ void kload2(bf16x8*kf,lds_cptr kp,int j){ kf[2*j]=*(const __attribute__((address_space(3))) bf16x8*)(kp+j*2048); kf[2*j+1]=*(const __attribute__((address_space(3))) bf16x8*)(kp+j*2048+512); }
__device__ __forceinline__ s16x4 vtr(lds_cptr p){ return __builtin_bit_cast(s16x4,__builtin_amdgcn_ds_read_tr16_b64_v4i16((__attribute__((address_space(3))) v4i16_t*)p)); }
__device__ __forceinline__ float rowmax(const f32x16&p0,const f32x16&p1){
  float a=max3f(p0[0],p0[1],p1[0]),b=max3f(p0[2],p0[3],p1[1]);a=max3f(a,p1[2],p1[3]);
  #pragma unroll
  for(int r=4;r<16;r+=4){a=max3f(a,p0[r],p0[r+1]);b=max3f(b,p0[r+2],p0[r+3]);a=max3f(a,p1[r],p1[r+1]);b=max3f(b,p1[r+2],p1[r+3]);}
  const float m=max2f(a,b);
  auto rr=__builtin_amdgcn_permlane32_swap(__float_as_uint(m),__float_as_uint(m),false,false);
  return max2f(__uint_as_float(rr[0]),__uint_as_float(rr[1]));
}
__device__ __forceinline__ void pv(f32x16*o,int vb,bf16x8 pa0,bf16x8 pa1,bf16x8 pa2,bf16x8 pa3){
  #pragma unroll
  for(int d0=0;d0<2;++d0){s16x4 lo[4],hi[4];
    #pragma unroll
    for(int ks=0;ks<4;++ks){
      asm volatile("ds_read_b64_tr_b16 %0,%1 offset:%c2":"=&v"(lo[ks]):"v"(vb),"i"(d0*4096+ks*1024):"memory");
      asm volatile("ds_read_b64_tr_b16 %0,%1 offset:%c2":"=&v"(hi[ks]):"v"(vb),"i"(d0*4096+ks*1024+512):"memory");}
    asm volatile("s_waitcnt lgkmcnt(0)":::"memory");SBAR();
    #define PK(k) (bf16x8){lo[k][0],lo[k][1],lo[k][2],lo[k][3],hi[k][0],hi[k][1],hi[k][2],hi[k][3]}
    o[d0]=__builtin_amdgcn_mfma_f32_32x32x16_bf16(pa0,PK(0),o[d0],0,0,0);
    o[d0]=__builtin_amdgcn_mfma_f32_32x32x16_bf16(pa1,PK(1),o[d0],0,0,0);
    o[d0]=__builtin_amdgcn_mfma_f32_32x32x16_bf16(pa2,PK(2),o[d0],0,0,0);
    o[d0]=__builtin_amdgcn_mfma_f32_32x32x16_bf16(pa3,PK(3),o[d0],0,0,0);
    #undef PK
  }
}

#ifndef ATTN_STORE16
#define ATTN_STORE16(p,v) (*(u32x4*)(p)=(v))
#endif
__device__ __forceinline__ int olane(){ int l; asm volatile("v_mbcnt_lo_u32_b32 %0, -1, 0\n\tv_mbcnt_hi_u32_b32 %0, -1, %0":"=v"(l)); return l; }
template<int THRL> __device__ __forceinline__ void attn_unit(const int wid,long rowbase,int qb,const bf16*Qc,const bf16*__restrict__ Kc,const bf16*__restrict__ Vc,bf16*Oc,char*shm){
  const int lane=olane(),r32=lane&31,hi=lane>>5;
  const int q0=qb*QB;
  const bf16*Qw=Qc+(rowbase+q0+wid*QBLK)*QP;
  const bf16*Kh=Kc+rowbase*KP,*Vh=Vc+rowbase*VP;
  const unsigned lds0=(unsigned)(uintptr_t)shm;
  float*wsf=(float*)(shm+LDS_WS)+wid*64;
  const bf16*ksrc=Kh+(long)lane*KP+wid*8;
  const bf16*vsrc=Vh+(long)(16*(wid&3)+(lane>>2))*VP+(wid>>2)*32+(lane&3)*8;
  const unsigned kdst=lds0+LDS_K+wid*1024, vdst=lds0+LDS_V+wid*1024;
  #define DMA_K(t,slot) glds16(ksrc+(long)(t)*KVBLK*KP,(unsigned)__builtin_amdgcn_readfirstlane(kdst+(slot)))
  #define DMA_V(t,slot) glds16(vsrc+(long)(t)*KVBLK*VP,(unsigned)__builtin_amdgcn_readfirstlane(vdst+(slot)))
  const int vb0=(int)(lds0+LDS_V)+((lane>>4)&1)*32+(lane&3)*8+(4*hi+((lane&15)>>2))*64;
  const char*Kbase=shm+LDS_K; bf16x8 kf[8];
  const lds_cptr shm3=(lds_cptr)shm; const lds_cptr kp0=shm3+LDS_K+hi*1024+r32*16; const lds_cptr vp0=shm3+LDS_V+((lane>>4)&1)*32+(lane&3)*8+(4*hi+((lane&15)>>2))*64;
  const int NT=(q0+QB)/KVBLK;
  DMA_K(0,0);DMA_V(0,0);DMA_K(1,SLOTB);
  bf16x8 qr[4];
  #pragma unroll
  for(int d0=0;d0<4;++d0)qr[d0]=*reinterpret_cast<const bf16x8*>(&Qw[(long)r32*QP+d0*16+hi*8]);
  float l_reg=0.f;f32x16 o[2];o[0]=f32x16{};o[1]=f32x16{};const f32x16 negm=f32x16{};
  const int qrel=wid*QBLK+r32;
  #define CMASK(P0,P1,t) do{int jb_=(t)-(NT-4); if(jb_>=0)cmask(P0,P1,jb_,qrel,hi);}while(0)
  #define START(P0,P1) do{ _Pragma("unroll") for(int r=0;r<16;++r)P0[r]=__builtin_amdgcn_exp2f(P0[r]); }while(0)
  #define RESC() do{}while(0)
  f32x16 pA0,pA1,pB0,pB1;
  int sl_prev=0,sl_cur=0,sl_next=SLOTB;
  #define ROT() do{sl_prev=sl_cur;sl_cur=sl_next;sl_next=(sl_next==(NSLOT-1)*SLOTB)?0:sl_next+SLOTB;}while(0)
  DMA_K(2,2*SLOTB);
  WAIT_BAR(3);
  qkt(pA0,pA1,Kbase,qr,negm,r32,hi);asm volatile("s_nop 15\n\ts_nop 7":"+v"(pA0),"+v"(pA1));CMASK(pA0,pA1,0);
  START(pA0,pA1);
  _Pragma("unroll") for(int r=0;r<16;++r)pA1[r]=__builtin_amdgcn_exp2f(pA1[r]);
  WAIT_BAR(0);
  DMA_K(3,0);DMA_V(1,SLOTB);
  ROT();
  kload8(kf,kp0+sl_cur);
  WAIT_BAR(2);
  s16x4 vlo[8],vhi[8]; u32x4 pw0,pw1,pw2,pw3;
  #define PKW(P,B) cvtpk_s(P[B],P[B+1])
  #define PAF(k) __builtin_bit_cast(bf16x8,pw##k)
  #define VFR(i) (bf16x8){vlo[i][0],vlo[i][1],vlo[i][2],vlo[i][3],vhi[i][0],vhi[i][1],vhi[i][2],vhi[i][3]}
  #define PIN(x) asm volatile("":"+v"(x))
  #define MX3(a,b,c) __builtin_fmaxf(__builtin_fmaxf((a),(b)),(c))
  #define GAPA(MF,A0,A1,A2,A3,W0,W1,PW) do{ MF; sacc+=A0; sacc+=A1; sacc+=A2; sacc+=A3; PIN(sacc); W0; W1; PIN(PW); SBAR(); }while(0)
  #define EX(v) __builtin_amdgcn_exp2f(v)
  #define GAPB(MF,X,B) do{ MF; X[B]=EX(X[B]); X[B+1]=EX(X[B+1]); X[B+2]=EX(X[B+2]); X[B+3]=EX(X[B+3]); PIN(X); SBAR(); }while(0)
  #define VRD(i) do{ vlo[i]=vtr(vp_+(((i)>>2)*4096+((i)&3)*1024)); vhi[i]=vtr(vp_+(((i)>>2)*4096+((i)&3)*1024+512)); }while(0)
  #define KRD(G,j) do{ if(G){ kload2(kf,kp0+sl_next,j); SBAR(); } }while(0)
  #define STEP(C0,C1,P0,P1,t,GK,GV,GL) do{ SBAR(); \
    const lds_cptr vp_=vp0+sl_prev; \
    VRD(0); SBAR(); float sacc=(P0[0]+P0[1]); \
    GAPA(C0=__builtin_amdgcn_mfma_f32_32x32x16_bf16(kf[0],qr[0],negm,0,0,0), P0[2],P0[3],P0[4],P0[5],     pw0[0]=PKW(P0,0), pw0[1]=PKW(P0,2), pw0); \
    VRD(4); SBAR(); GAPA(C1=__builtin_amdgcn_mfma_f32_32x32x16_bf16(kf[1],qr[0],negm,0,0,0), P0[6],P0[7],P0[8],P0[9],     pw0[2]=PKW(P0,4), pw0[3]=PKW(P0,6), pw0); \
    VRD(1); SBAR(); GAPA(C0=__builtin_amdgcn_mfma_f32_32x32x16_bf16(kf[2],qr[1],C0,0,0,0),   P0[10],P0[11],P0[12],P0[13], pw1[0]=PKW(P0,8), pw1[1]=PKW(P0,10), pw1); \
    VRD(5); SBAR(); GAPA(C1=__builtin_amdgcn_mfma_f32_32x32x16_bf16(kf[3],qr[1],C1,0,0,0),   P0[14],P0[15],P1[0],P1[1],   pw1[2]=PKW(P0,12),pw1[3]=PKW(P0,14), pw1); \
    VRD(2); SBAR(); GAPA(C0=__builtin_amdgcn_mfma_f32_32x32x16_bf16(kf[4],qr[2],C0,0,0,0),   P1[2],P1[3],P1[4],P1[5],     pw2[0]=PKW(P1,0), pw2[1]=PKW(P1,2), pw2); \
    VRD(6); SBAR(); GAPA(C1=__builtin_amdgcn_mfma_f32_32x32x16_bf16(kf[5],qr[2],C1,0,0,0),   P1[6],P1[7],P1[8],P1[9],     pw2[2]=PKW(P1,4), pw2[3]=PKW(P1,6), pw2); \
    VRD(3); SBAR(); GAPA(C0=__builtin_amdgcn_mfma_f32_32x32x16_bf16(kf[6],qr[3],C0,0,0,0),   P1[10],P1[11],P1[12],P1[13], pw3[0]=PKW(P1,8), pw3[1]=PKW(P1,10), pw3); \
    VRD(7); SBAR(); GAPA(C1=__builtin_amdgcn_mfma_f32_32x32x16_bf16(kf[7],qr[3],C1,0,0,0),   P1[14],P1[15],0.f,0.f,       pw3[2]=PKW(P1,12),pw3[3]=PKW(P1,14), pw3); \
    l_reg+=sacc; \
    if(GK){DMA_K((t)+3,sl_cur);} if(GV){DMA_V((t)+1,sl_next);} \
    CMASK(C0,C1,t); \
    SBAR(); \
    GAPB(o[0]=__builtin_amdgcn_mfma_f32_32x32x16_bf16(PAF(0),VFR(0),o[0],0,0,0), C0,0); \
    GAPB(o[1]=__builtin_amdgcn_mfma_f32_32x32x16_bf16(PAF(0),VFR(4),o[1],0,0,0), C0,4); \
    KRD(GL,0); GAPB(o[0]=__builtin_amdgcn_mfma_f32_32x32x16_bf16(PAF(1),VFR(1),o[0],0,0,0), C0,8); \
    KRD(GL,1); GAPB(o[1]=__builtin_amdgcn_mfma_f32_32x32x16_bf16(PAF(1),VFR(5),o[1],0,0,0), C0,12); \
    KRD(GL,2); GAPB(o[0]=__builtin_amdgcn_mfma_f32_32x32x16_bf16(PAF(2),VFR(2),o[0],0,0,0), C1,0); \
    KRD(GL,3); GAPB(o[1]=__builtin_amdgcn_mfma_f32_32x32x16_bf16(PAF(2),VFR(6),o[1],0,0,0), C1,4); \
    GAPB(o[0]=__builtin_amdgcn_mfma_f32_32x32x16_bf16(PAF(3),VFR(3),o[0],0,0,0), C1,8); \
    GAPB(o[1]=__builtin_amdgcn_mfma_f32_32x32x16_bf16(PAF(3),VFR(7),o[1],0,0,0), C1,12); \
    }while(0)
  int t=1;
  #undef CMASK
  #define CMASK(P0,P1,t) do{}while(0)
  for(;t+5<NT;t+=2){
    STEP(pB0,pB1,pA0,pA1,t,true,true,true);     WAIT_BAR(2); RESC(); ROT();
    STEP(pA0,pA1,pB0,pB1,t+1,true,true,true);   WAIT_BAR(2); RESC(); ROT();
  }
  #undef CMASK
  #define CMASK(P0,P1,t) do{int jb_=(t)-(NT-4); if(jb_>=0)cmask(P0,P1,jb_,qrel,hi);}while(0)
  #define ENDW(tt) do{ if((tt)+3<NT){WAIT_BAR(2);} else if((tt)+2<NT){WAIT_BAR(1);} else {WAIT_BAR(0);} }while(0)
  for(;t+1<NT;t+=2){
    STEP(pB0,pB1,pA0,pA1,t,(t+3<NT),(t+1<NT),(t+1<NT));       ENDW(t);   RESC(); ROT();
    STEP(pA0,pA1,pB0,pB1,t+1,(t+4<NT),(t+2<NT),(t+2<NT));     ENDW(t+1); RESC(); ROT();
  }
  STEP(pB0,pB1,pA0,pA1,NT-1,false,false,false); RESC();
  { float sacc=pB0[0]+pB0[1]; _Pragma("unroll") for(int r=2;r<16;++r)sacc+=pB0[r]; _Pragma("unroll") for(int r=0;r<16;++r)sacc+=pB1[r]; l_reg+=sacc;
    pw0=(u32x4){PKW(pB0,0),PKW(pB0,2),PKW(pB0,4),PKW(pB0,6)};pw1=(u32x4){PKW(pB0,8),PKW(pB0,10),PKW(pB0,12),PKW(pB0,14)};pw2=(u32x4){PKW(pB1,0),PKW(pB1,2),PKW(pB1,4),PKW(pB1,6)};pw3=(u32x4){PKW(pB1,8),PKW(pB1,10),PKW(pB1,12),PKW(pB1,14)};
    SBAR(); pv(o,vb0+sl_cur,PAF(0),PAF(1),PAF(2),PAF(3)); }
  #undef PKW
  #undef PAF
  #undef VFR
  #undef PIN
  #undef MX3
  #undef GAPA
  #undef GAPB
  #undef EX
  #undef VRD
  #undef KRD
  #undef STEP
  #undef ENDW
  {auto rr=__builtin_amdgcn_permlane32_swap(__float_as_uint(l_reg),__float_as_uint(l_reg),false,false);l_reg=__uint_as_float(rr[0])+__uint_as_float(rr[1]);}
  const int le=olane(),r32e=le&31,hie=le>>5;
  if(hie==0)wsf[32+r32e]=l_reg;asm volatile("s_waitcnt lgkmcnt(0)":::"memory");
  float rli[16];
  #pragma unroll
  for(int r=0;r<16;++r)rli[r]=__builtin_amdgcn_rcpf(wsf[32+crow(r,hie)]);
  bf16*Ow=Oc+(rowbase+q0+wid*QBLK)*OP;
  { bf16*stg=(bf16*)(shm+LDS_OST)+wid*2048;
    #pragma unroll
    for(int r=0;r<16;++r){const int orow=crow(r,hie);
      #pragma unroll
      for(int d0=0;d0<2;++d0)stg[orow*64+d0*32+r32e]=__float2bfloat16(o[d0][r]*rli[r]);}
    asm volatile("s_waitcnt lgkmcnt(0)":::"memory");
    #pragma unroll
    for(int i=0;i<4;++i){const int row=i*8+(le>>3),ch=le&7; const u32x4 v=*(const u32x4*)(stg+row*64+ch*8); ATTN_STORE16(Ow+(long)row*OP+ch*8,v);} }
  asm volatile("s_waitcnt lgkmcnt(0)\n\ts_barrier":::"memory");
  #undef DMA_K
  #undef DMA_V
  #undef CMASK
  #undef START
  #undef RESC
  #undef ROT
}
constexpr int ATTN_LDS_BYTES=LDS_BYTES;
#undef SBAR
#undef WAIT_BAR
}
namespace attn_body {
#define SBAR() __builtin_amdgcn_sched_barrier(0)
#define WAIT_BAR(N) asm volatile("s_waitcnt vmcnt(" #N ") lgkmcnt(0)\n\ts_barrier":::"memory")
constexpr int KSLOT=8192, VSLOT=16384;
constexpr int L2_K=0, L2_V=NSLOT*KSLOT, L2_WS=L2_V+NSLOT*VSLOT, L2_OST=L2_WS+NW*64*4, L2_BYTES=L2_OST+NW*4096;
constexpr int L2_PRE=L2_V+2*VSLOT, L2_PRE_WAVE=6144;
static_assert(L2_PRE+NW*L2_PRE_WAVE<=L2_BYTES,"prologue side-job scratch");
template<class Pre,class Post> __device__ __forceinline__ void attn_unit2(const int wid,long rowbase,int qb,const bf16*Qc,const bf16*__restrict__ Kc,const bf16*__restrict__ Vc,bf16*Oc,char*shm,const Pre&pre,const Post&post){
  const int lane=olane(),r32=lane&31,hi=lane>>5;
  typename Pre::Regs prg; pre.issue(prg,lane);
  const int q0=qb*QB;
  const bf16*Qw=Qc+(rowbase+q0+wid*QBLK)*QP;
  const bf16*Kh=Kc+rowbase*KP,*Vh=Vc+rowbase*VP;
  const unsigned lds0=(unsigned)(uintptr_t)shm;
  float*wsf=(float*)(shm+L2_WS)+wid*64;
  const bf16*ksrc=Kh+(long)lane*KP+wid*8;
  const bf16*vsrc=Vh+(long)(16*(wid&3)+(lane>>2))*VP+(wid>>2)*32+(lane&3)*8;
  const unsigned kdst=lds0+L2_K+wid*1024, vdst=lds0+L2_V+wid*1024;
  #define DMA_K(t,ks) glds16(ksrc+(long)(t)*KVBLK*KP,(unsigned)__builtin_amdgcn_readfirstlane(kdst+(ks)))
  #define DMA_V(t,ks) do{ glds16(vsrc+(long)(t)*KVBLK*VP,(unsigned)__builtin_amdgcn_readfirstlane(vdst+2*(ks))); glds16(vsrc+(long)(t)*KVBLK*VP+64,(unsigned)__builtin_amdgcn_readfirstlane(vdst+2*(ks)+8192)); }while(0)
  const char*Kbase=shm+L2_K; bf16x8 kf[8];
  const lds_cptr shm3=(lds_cptr)shm; const lds_cptr kp0=shm3+L2_K+hi*1024+r32*16; const lds_cptr vp0=shm3+L2_V+((lane>>4)&1)*32+(lane&3)*8+(4*hi+((lane&15)>>2))*64;
  const int NT=(q0+QB)/KVBLK;
  DMA_K(0,0);DMA_V(0,0);DMA_K(1,KSLOT);
  bf16x8 qr[4];
  #pragma unroll
  for(int d0=0;d0<4;++d0)qr[d0]=*reinterpret_cast<const bf16x8*>(&Qw[(long)r32*QP+d0*16+hi*8]);
  float l_reg=0.f;f32x16 o[4];o[0]=f32x16{};o[1]=f32x16{};o[2]=f32x16{};o[3]=f32x16{};const f32x16 zc=f32x16{};
  const int qrel=wid*QBLK+r32;
  f32x16 C0,C1;
  s16x4 vlo[8],vhi[8]; u32x4 pw0,pw1,pw2,pw3;
  int sl_prev=0,sl_cur=0,sl_next=KSLOT;
  #define ROT() do{sl_prev=sl_cur;sl_cur=sl_next;sl_next=(sl_next==(NSLOT-1)*KSLOT)?0:sl_next+KSLOT;}while(0)
  #define PKW(P,B) cvtpk_s(P[B],P[B+1])
  #define PAF(k) __builtin_bit_cast(bf16x8,pw##k)
  #define VFR(i) (bf16x8){vlo[i][0],vlo[i][1],vlo[i][2],vlo[i][3],vhi[i][0],vhi[i][1],vhi[i][2],vhi[i][3]}
  #define PIN(x) asm volatile("":"+v"(x))
  #define EX(v) __builtin_amdgcn_exp2f(v)
  #define VRD(H,i) do{ vlo[i]=vtr(vp_+((2*(H)+((i)>>2))*4096+((i)&3)*1024)); vhi[i]=vtr(vp_+((2*(H)+((i)>>2))*4096+((i)&3)*1024+512)); }while(0)
  #define PACK(PW,P,B) do{ sacc+=P[B]; sacc+=P[B+1]; sacc+=P[B+2]; sacc+=P[B+3]; sacc+=P[B+4]; sacc+=P[B+5]; sacc+=P[B+6]; sacc+=P[B+7]; PIN(sacc); \
      PW[0]=PKW(P,B); PW[1]=PKW(P,B+2); PW[2]=PKW(P,B+4); PW[3]=PKW(P,B+6); PIN(PW); }while(0)
  DMA_K(2,2*KSLOT);
  pre.finish(prg,(__attribute__((address_space(3))) unsigned char*)(shm3+L2_PRE+wid*L2_PRE_WAVE),lane);
  WAIT_BAR(4);
  qkt(C0,C1,Kbase,qr,zc,r32,hi);
  { const int jb_=0-(NT-4); if(jb_>=0)cmask(C0,C1,jb_,qrel,hi); }
  #pragma unroll
  for(int r=0;r<16;++r){C0[r]=EX(C0[r]);C1[r]=EX(C1[r]);}
  { float sacc=0.f; PACK(pw0,C0,0); PACK(pw1,C0,8); PACK(pw2,C1,0); PACK(pw3,C1,8); l_reg+=sacc; }
  WAIT_BAR(0);
  DMA_K(3,0);DMA_V(1,KSLOT);
  ROT();
  kload8(kf,kp0+sl_cur);
  WAIT_BAR(3);
  for(int t=1;t<NT;++t){
    const bool gk=(t+3<NT), gv=(t+1<NT);
    const lds_cptr vp_=vp0+2*sl_prev;
    SBAR();
    VRD(0,0); SBAR(); C0=__builtin_amdgcn_mfma_f32_32x32x16_bf16(kf[0],qr[0],zc,0,0,0); SBAR();
    VRD(0,4); SBAR(); C1=__builtin_amdgcn_mfma_f32_32x32x16_bf16(kf[1],qr[0],zc,0,0,0); SBAR();
    VRD(0,1); SBAR(); C0=__builtin_amdgcn_mfma_f32_32x32x16_bf16(kf[2],qr[1],C0,0,0,0); SBAR();
    VRD(0,5); SBAR(); C1=__builtin_amdgcn_mfma_f32_32x32x16_bf16(kf[3],qr[1],C1,0,0,0); SBAR();
    VRD(0,2); SBAR(); C0=__builtin_amdgcn_mfma_f32_32x32x16_bf16(kf[4],qr[2],C0,0,0,0); SBAR();
    VRD(0,6); SBAR(); C1=__builtin_amdgcn_mfma_f32_32x32x16_bf16(kf[5],qr[2],C1,0,0,0); SBAR();
    VRD(0,3); SBAR(); C0=__builtin_amdgcn_mfma_f32_32x32x16_bf16(kf[6],qr[3],C0,0,0,0); SBAR();
    VRD(0,7); SBAR(); C1=__builtin_amdgcn_mfma_f32_32x32x16_bf16(kf[7],qr[3],C1,0,0,0); SBAR();
    if(gk){DMA_K(t+3,sl_cur);} if(gv){DMA_V(t+1,sl_next);}
    { const int jb_=t-(NT-4); if(jb_>=0)cmask(C0,C1,jb_,qrel,hi); }
    SBAR();
    #define GAPB(MF,X,B,VI) do{ MF; X[B]=EX(X[B]); X[B+1]=EX(X[B+1]); X[B+2]=EX(X[B+2]); X[B+3]=EX(X[B+3]); PIN(X); VRD(1,VI); SBAR(); }while(0)
    GAPB(o[0]=__builtin_amdgcn_mfma_f32_32x32x16_bf16(PAF(0),VFR(0),o[0],0,0,0), C0,0, 0);
    GAPB(o[1]=__builtin_amdgcn_mfma_f32_32x32x16_bf16(PAF(0),VFR(4),o[1],0,0,0), C0,4, 4);
    GAPB(o[0]=__builtin_amdgcn_mfma_f32_32x32x16_bf16(PAF(1),VFR(1),o[0],0,0,0), C0,8, 1);
    GAPB(o[1]=__builtin_amdgcn_mfma_f32_32x32x16_bf16(PAF(1),VFR(5),o[1],0,0,0), C0,12,5);
    GAPB(o[0]=__builtin_amdgcn_mfma_f32_32x32x16_bf16(PAF(2),VFR(2),o[0],0,0,0), C1,0, 2);
    GAPB(o[1]=__builtin_amdgcn_mfma_f32_32x32x16_bf16(PAF(2),VFR(6),o[1],0,0,0), C1,4, 6);
    GAPB(o[0]=__builtin_amdgcn_mfma_f32_32x32x16_bf16(PAF(3),VFR(3),o[0],0,0,0), C1,8, 3);
    GAPB(o[1]=__builtin_amdgcn_mfma_f32_32x32x16_bf16(PAF(3),VFR(7),o[1],0,0,0), C1,12,7);
    #undef GAPB
    float sacc=0.f;
    o[2]=__builtin_amdgcn_mfma_f32_32x32x16_bf16(PAF(0),VFR(0),o[2],0,0,0); if(gv){kload2(kf,kp0+sl_next,0);} SBAR();
    o[3]=__builtin_amdgcn_mfma_f32_32x32x16_bf16(PAF(0),VFR(4),o[3],0,0,0); PACK(pw0,C0,0); if(gv){kload2(kf,kp0+sl_next,1);} SBAR();
    o[2]=__builtin_amdgcn_mfma_f32_32x32x16_bf16(PAF(1),VFR(1),o[2],0,0,0); if(gv){kload2(kf,kp0+sl_next,2);} SBAR();
    o[3]=__builtin_amdgcn_mfma_f32_32x32x16_bf16(PAF(1),VFR(5),o[3],0,0,0); PACK(pw1,C0,8); if(gv){kload2(kf,kp0+sl_next,3);} SBAR();
    o[2]=__builtin_amdgcn_mfma_f32_32x32x16_bf16(PAF(2),VFR(2),o[2],0,0,0); SBAR();
    o[3]=__builtin_amdgcn_mfma_f32_32x32x16_bf16(PAF(2),VFR(6),o[3],0,0,0); PACK(pw2,C1,0); SBAR();
    o[2]=__builtin_amdgcn_mfma_f32_32x32x16_bf16(PAF(3),VFR(3),o[2],0,0,0); SBAR();
    o[3]=__builtin_amdgcn_mfma_f32_32x32x16_bf16(PAF(3),VFR(7),o[3],0,0,0); PACK(pw3,C1,8); SBAR();
    l_reg+=sacc;
    if(t+3<NT){WAIT_BAR(3);} else if(t+2<NT){WAIT_BAR(2);} else if(t+1<NT){WAIT_BAR(0);}
    ROT();
  }
  typename Post::Regs pq; post.prefetch(pq,wid*64+lane);
  { const int vb=(int)(lds0+L2_V)+((lane>>4)&1)*32+(lane&3)*8+(4*hi+((lane&15)>>2))*64+2*sl_prev;
    SBAR(); pv(o,vb,PAF(0),PAF(1),PAF(2),PAF(3)); pv(o+2,vb+8192,PAF(0),PAF(1),PAF(2),PAF(3)); }
  #undef PKW
  #undef PAF
  #undef VFR
  #undef PIN
  #undef EX
  #undef VRD
  #undef PACK
  {auto rr=__builtin_amdgcn_permlane32_swap(__float_as_uint(l_reg),__float_as_uint(l_reg),false,false);l_reg=__uint_as_float(rr[0])+__uint_as_float(rr[1]);}
  const int le=olane(),r32e=le&31,hie=le>>5;
  if(hie==0)wsf[32+r32e]=l_reg;asm volatile("s_waitcnt lgkmcnt(0)":::"memory");
  float rli[16];
  #pragma unroll
  for(int r=0;r<16;++r)rli[r]=__builtin_amdgcn_rcpf(wsf[32+crow(r,hie)]);
  bf16*Ow=Oc+(rowbase+q0+wid*QBLK)*OP;
  bf16*stg=(bf16*)(shm+L2_OST)+wid*2048;
  #pragma unroll
  for(int hf=0;hf<2;++hf){
    #pragma unroll
    for(int r=0;r<16;++r){const int orow=crow(r,hie);
      #pragma unroll
      for(int d0=0;d0<2;++d0)stg[orow*64+d0*32+r32e]=__float2bfloat16(o[2*hf+d0][r]*rli[r]);}
    asm volatile("s_waitcnt lgkmcnt(0)":::"memory");
    #pragma unroll
    for(int i=0;i<4;++i){const int row=i*8+(le>>3),ch=le&7; const u32x4 v=*(const u32x4*)(stg+row*64+ch*8); ATTN_STORE16(Ow+(long)row*OP+hf*64+ch*8,v);}
    asm volatile("s_waitcnt lgkmcnt(0)":::"memory");
  }
  asm volatile("s_waitcnt lgkmcnt(0)\n\ts_barrier":::"memory");
  post.run(pq,wid,le);
  #undef DMA_K
  #undef DMA_V
  #undef ROT
}
constexpr int ATTN2_LDS_BYTES=L2_BYTES;
#undef SBAR
#undef WAIT_BAR
}
constexpr int NWAVES = 8;
constexpr int NPH = 8;
#ifndef MK_N_LAUNCHES
#define MK_N_LAUNCHES 1
#endif
constexpr int N_LAUNCHES = MK_N_LAUNCHES;
static_assert(N_LAUNCHES == 1 || N_LAUNCHES == NPH, "MK_N_LAUNCHES is 1 or 8");

constexpr int BATCH = 16, SEQ = 2048, T = BATCH * SEQ, D = 1024, INC = 2560, NE = 32, FF = 512, ECAP = T;
constexpr float RMS_EPS = 1e-6f;
constexpr float LAMBDA_INIT = 0.2f;

constexpr size_t MiB = 1u << 20;
constexpr size_t WS_CTL = 0, CTL_ZERO_BYTES = 65536;
constexpr size_t WS_WIN = 2 * MiB;
constexpr size_t WS_WOUT = 7 * MiB;
constexpr size_t WS_WR = 9 * MiB;
constexpr size_t WS_SGW = 10 * MiB;
constexpr size_t WS_ROPE = 11 * MiB;
constexpr size_t WS_RSTD1 = 13 * MiB;
constexpr size_t WS_RSTD2 = 13 * MiB + 512 * 1024;
constexpr size_t WS_SVST = 14 * MiB;
constexpr size_t WS_HST = 16 * MiB;
constexpr size_t WS_ELIST = 18 * MiB;
constexpr size_t WS_PGATE = 22 * MiB;
constexpr size_t WS_W1 = 24 * MiB;
constexpr size_t WS_EVALS = 56 * MiB;
constexpr size_t WS_W2 = 88 * MiB;
constexpr size_t WS_XB = 120 * MiB;
constexpr size_t WS_Q = 184 * MiB, WS_K = 216 * MiB, WS_V = 248 * MiB, WS_SU = 280 * MiB, WS_SV = 312 * MiB;
constexpr size_t WS_Y = 184 * MiB;
constexpr size_t WS_MIX = 344 * MiB;
constexpr size_t WS_HB = 408 * MiB;
constexpr size_t WS_H8 = 472 * MiB;
constexpr size_t WS_END = 504 * MiB;
constexpr int CW_TMO = 0, CW_CODE = 1;
constexpr int CW_BAR = 4096;
constexpr int CW_Q7 = 2048;
constexpr int CW_GRP = 12288;
constexpr int CW_XID = 14848;
constexpr int CW_CNT = 8192;
static_assert((CW_CNT + 64 * NE) * 4 <= (int)CTL_ZERO_BYTES && CW_GRP + 64 * 40 <= CW_XID && (CW_XID + 256) * 4 <= (int)CTL_ZERO_BYTES, "CTL words inside the memset region");

constexpr int RING_OFF = 0, RING_BYTES = 131072;
constexpr int LCTL_OFF = RING_BYTES;
constexpr int L_MISC = LCTL_OFF, L_TSTART = LCTL_OFF + 64, L_RSTART = LCTL_OFF + 256, L_CNT = LCTL_OFF + 448, L_HIST = LCTL_OFF + 576, L_BASE = LCTL_OFF + 704;
constexpr int L_ULIST = LCTL_OFF + 1024;
constexpr int L_ROWTAB = LCTL_OFF + 2048;
constexpr int LDS_BYTES = 147456;
#define GAS __attribute__((address_space(1)))
#define LAS __attribute__((address_space(3)))
typedef unsigned short bf16;
typedef unsigned v4u __attribute__((ext_vector_type(4)));
typedef float f32x4 __attribute__((ext_vector_type(4)));
typedef short bf16x8 __attribute__((ext_vector_type(8)));
typedef GAS unsigned gu32;
typedef GAS unsigned long long gu64;
#define RLX_AGENT __ATOMIC_RELAXED, __HIP_MEMORY_SCOPE_AGENT
#define LDS_WAIT() asm volatile("s_waitcnt lgkmcnt(0)" ::: "memory")
#define VM_WAIT() asm volatile("s_waitcnt vmcnt(0)" ::: "memory")
__device__ __forceinline__ unsigned long long rt() { return __builtin_amdgcn_s_memrealtime(); }
__device__ __forceinline__ unsigned f2bf(float f) { unsigned u = __builtin_bit_cast(unsigned, f); return (u + 0x7fffu + ((u >> 16) & 1u)) >> 16; }
__device__ __forceinline__ unsigned pk2(float lo, float hi) { return f2bf(lo) | (f2bf(hi) << 16); }

#define XB_TMO      128
#define XB_XCNT(j)  (256  + 64 * (j))
#define XB_XSUB(j)  (1280 + 64 * (j))
#define XB_XGEN(j)  (2304 + 64 * (j))
#define XB_TOP      3328
#define XB_TOPGEN   3392
#define XCD_BAR_WORDS 3456
#define XB_SPIN_CAP (1u << 18)

__device__ __forceinline__ unsigned xb_ld(unsigned* p)              { return __hip_atomic_load(p, __ATOMIC_RELAXED, __HIP_MEMORY_SCOPE_AGENT); }
__device__ __forceinline__ unsigned xb_add(unsigned* p, unsigned v) { return __hip_atomic_fetch_add(p, v, __ATOMIC_RELAXED, __HIP_MEMORY_SCOPE_AGENT); }
__device__ __forceinline__ unsigned xb_xcc_id() { return (unsigned)__builtin_amdgcn_s_getreg((3 << 11) | 20) & 0xFu; }
#define XB_SPIN(cond, bar) do { unsigned _sp = 0; while (cond) { __builtin_amdgcn_s_sleep(1); \
    if ((++_sp & 255u) == 0u) { if (xb_ld(&(bar)[XB_TMO])) break; if (_sp > XB_SPIN_CAP) { atomicAdd(&(bar)[XB_TMO], 1u); break; } } } } while (0)

struct XcdBarrier {
    unsigned* bar; unsigned x;
    volatile LAS unsigned* st;
};

__device__ __forceinline__ XcdBarrier xcd_barrier_post(unsigned* bar, volatile LAS unsigned* st, const bool t0  ) {
    XcdBarrier b; b.bar = bar; b.x = xb_xcc_id(); b.st = st;
    if (t0) (void)xb_add(&bar[XB_XCNT(b.x)], 1u);
    return b;
}
__device__ __forceinline__ void xcd_barrier_complete(unsigned* bar, unsigned x, unsigned& nloc, unsigned& nx) {
    const unsigned G = gridDim.x * gridDim.y * gridDim.z;
    unsigned sum, cnt, mine, sp = 0u;
    for (;;) {
        sum = 0u; cnt = 0u; mine = 0u;
#pragma unroll
        for (unsigned j = 0; j < 16; ++j) { const unsigned c = xb_ld(&bar[XB_XCNT(j)]); sum += c; cnt += (c > 0u) ? 1u : 0u; mine = (j == x) ? c : mine; }
        if (sum == G) break;
        __builtin_amdgcn_s_sleep(1);
        if ((++sp & 255u) == 0u) { if (xb_ld(&bar[XB_TMO])) break; if (sp > XB_SPIN_CAP) { atomicAdd(&bar[XB_TMO], 1u); break; } }
    }
    nloc = mine > 0u ? mine : 1u; nx = cnt > 0u ? cnt : 1u;
}

__device__ __forceinline__ void xcd_barrier(const XcdBarrier& b, const bool t0  ) {
    asm volatile("s_waitcnt vmcnt(0)" ::: "memory");
    __syncthreads();
    if (t0) {
        unsigned* bar = b.bar;
        __builtin_amdgcn_s_waitcnt(0);
        unsigned nloc = b.st[0], nx = b.st[1];
        if (nloc == 0u) { xcd_barrier_complete(bar, b.x, nloc, nx); b.st[0] = nloc; b.st[1] = nx; }
        const unsigned old = xb_add(&bar[XB_XSUB(b.x)], 1u);
        const unsigned gen = old / nloc;
        if (old + 1u == (gen + 1u) * nloc) {
            __builtin_amdgcn_fence(__ATOMIC_RELEASE, "agent");
            asm volatile("s_waitcnt vmcnt(0)" ::: "memory");
            const unsigned og = xb_add(&bar[XB_TOP], 1u);
            const unsigned tg = og / nx;
            if (og + 1u == (tg + 1u) * nx) xb_add(&bar[XB_TOPGEN], 1u);
            else XB_SPIN(xb_ld(&bar[XB_TOPGEN]) == tg, bar);
            __builtin_amdgcn_fence(__ATOMIC_ACQUIRE, "agent");
            xb_add(&bar[XB_XGEN(b.x)], 1u);
            asm volatile("s_waitcnt vmcnt(0)" ::: "memory");
        } else {
            XB_SPIN(xb_ld(&bar[XB_XGEN(b.x)]) == gen, bar);
            __builtin_amdgcn_fence(__ATOMIC_ACQUIRE, "agent");
            asm volatile("s_waitcnt vmcnt(0)" ::: "memory");
        }
    }
    __syncthreads();
}
__device__ __forceinline__ void grp_barrier(unsigned* bar, unsigned* word, const unsigned target, const bool same, const bool t0) {
    asm volatile("s_waitcnt vmcnt(0)" ::: "memory");
    __syncthreads();
    if (t0) {
        __builtin_amdgcn_s_waitcnt(0);
        if (!same) { __builtin_amdgcn_fence(__ATOMIC_RELEASE, "agent"); asm volatile("s_waitcnt vmcnt(0)" ::: "memory"); }
        (void)xb_add(word, 1u);
        XB_SPIN(xb_ld(word) < target, bar);
        __builtin_amdgcn_fence(__ATOMIC_ACQUIRE, "agent");
        asm volatile("s_waitcnt vmcnt(0)" ::: "memory");
    }
    __syncthreads();
}
#ifndef PROBE_PHASE
#define PROBE_PHASE -1
#endif
typedef unsigned u32x2_t __attribute__((ext_vector_type(2)));
typedef float f32x2_t __attribute__((ext_vector_type(2)));
struct InvFreq { float f[8]; };
struct Args { const float* in[25]; float* out; unsigned char* ws; InvFreq ifq; int ph_lo, ph_hi; };
struct Frame {
    LAS unsigned char* lds;
    gu32* ctl;
    int wave;
    int vcu, G;
    int grp;
    int gx, gr, gp;
    float* out; unsigned char* ws;
};
#ifndef SGU_IN_ATTN
#define SGU_IN_ATTN 0
#endif
#ifndef DYN_P7
#define DYN_P7 0
#endif
#ifndef USE_NT
#define USE_NT 1
#endif
#if USE_NT
#define NT_LOAD(p) __builtin_nontemporal_load(p)
#define NT_STORE(v, p) __builtin_nontemporal_store(v, p)
#else
#define NT_LOAD(p) (*(p))
#define NT_STORE(v, p) (*(p) = (v))
#endif
__device__ __forceinline__ int olane() { int l; asm volatile("v_mbcnt_lo_u32_b32 %0, -1, 0\n\tv_mbcnt_hi_u32_b32 %0, -1, %0" : "=v"(l)); return l; }
#define otid() (F.wave * 64 + olane())
template <int MASK> __device__ __forceinline__ float sxor(float v) { return __builtin_bit_cast(float, __builtin_amdgcn_ds_swizzle(__builtin_bit_cast(int, v), (MASK << 10) | 0x1f)); }
__device__ __forceinline__ float sum32(float v) { auto r = __builtin_amdgcn_permlane32_swap(__float_as_uint(v), __float_as_uint(v), false, false); return __uint_as_float(r[0]) + __uint_as_float(r[1]); }
__device__ __forceinline__ float wave_sum(float v) { v += sxor<1>(v); v += sxor<2>(v); v += sxor<4>(v); v += sxor<8>(v); v += sxor<16>(v); return sum32(v); }
__device__ __forceinline__ float bflo(unsigned w) { return __uint_as_float(w << 16); }
__device__ __forceinline__ float bfhi(unsigned w) { return __uint_as_float(w & 0xffff0000u); }
__device__ __forceinline__ unsigned cvtpk(float lo, float hi) { return pg8::cvt_pk_bf16(lo, hi); }

struct RmIn  { __device__ __forceinline__ int operator()(int n) const { const int G = n >> 6, lc = n & 63, fq = lc >> 4, bj = (lc >> 3) & 1, e = lc & 7, pn = G >> 2, wc = G & 3; return 256 * pn + 128 * bj + 32 * wc + 8 * fq + e; } };
struct RmId  { __device__ __forceinline__ int operator()(int n) const { return n; } };
struct RmGU  { int add; __device__ __forceinline__ int operator()(int f) const { return (f >> 7) * 256 + add + (f & 127); } };
struct P0Item { const float* W; const float* gk; bf16* WT; int N, Kd, k0, n0, kind, add; float f8s; };
constexpr int P0_I_IN = (D / 64) * (INC / 64), P0_I_OUT = (D / 64) * (D / 64), P0_I_GU = (D / 64) * (FF / 64), P0_I_DN = (FF / 64) * (D / 64);
constexpr int P0_NITEMS = P0_I_IN + P0_I_OUT;
constexpr int W1_NITEMS = NE * 2 * P0_I_GU, W2_NITEMS = NE * P0_I_DN;
__device__ __forceinline__ P0Item p0_decode(const Args& A, unsigned char* ws, int it) {
    P0Item d; int r = it;
    if (r < P0_I_IN) { d.W = A.in[3]; d.gk = A.in[2]; d.WT = (bf16*)(ws + WS_WIN); d.N = INC; d.Kd = D; d.kind = 3; d.add = 0; d.f8s = 0.f; }
    else if ((r -= P0_I_IN) < P0_I_OUT) { d.W = A.in[16]; d.gk = nullptr; d.WT = (bf16*)(ws + WS_WOUT); d.N = D; d.Kd = D; d.kind = 1; d.add = 0; d.f8s = 0.f; }
    else { d.W = nullptr; d.gk = nullptr; d.WT = nullptr; d.N = 64; d.Kd = 0; d.kind = 1; d.add = 0; d.f8s = 0.f; }
    const int nblk = d.N / 64; d.k0 = 64 * (r / nblk); d.n0 = 64 * (r % nblk); return d;
}
__device__ __forceinline__ P0Item decode_w1(const Args& A, unsigned char* ws, int r) {
    P0Item d; const int e = r >> 8, q = r & 255, up = q >> 7, rr = q & 127;
    d.W = (up ? A.in[23] : A.in[22]) + (size_t)e * D * FF; d.gk = A.in[17]; d.WT = (bf16*)(ws + WS_W1 + (size_t)e * 1024 * 1024); d.N = FF; d.Kd = D; d.kind = 2; d.add = up ? 128 : 0; d.f8s = pg8::W1_SCALE;
    d.k0 = 64 * (rr >> 3); d.n0 = 64 * (rr & 7); return d;
}
__device__ __forceinline__ P0Item decode_w2(const Args& A, unsigned char* ws, int r) {
    P0Item d; const int e = r >> 7, rr = r & 127;
    d.W = A.in[24] + (size_t)e * FF * D; d.gk = nullptr; d.WT = (bf16*)(ws + WS_W2 + (size_t)e * 1024 * 512); d.N = D; d.Kd = FF; d.kind = 0  ; d.add = 0; d.f8s = pg8::W2_SCALE;
    d.k0 = 64 * (rr >> 4); d.n0 = 64 * (rr & 15); return d;
}
__device__ __forceinline__ int p0_rowmap(int kind, int add, int n) {
    if (kind == 0) { const int G = n >> 6, lc = n & 63, fq = lc >> 4, bj = (lc >> 3) & 1, e = lc & 7, pn = G >> 2, wc = G & 3; return 256 * pn + 128 * bj + 32 * wc + 8 * fq + e; }
    if (kind == 1) return n;
    if (kind == 3) { const int G = n >> 6, lc = n & 63, bj = lc >> 5, fq = (lc >> 3) & 3, e = lc & 7, pn = G >> 2, wc = G & 3; return 256 * pn + 128 * bj + 32 * wc + 8 * fq + e; }
    return (n >> 7) * 256 + add + (n & 127);
}
__device__ __forceinline__ void p0_load(const P0Item& d, f32x4 (&v)[16], f32x4 (&g)[4], int lane) {
    const int kr = lane >> 4, nc = lane & 15;
    const float* src = d.W + (size_t)(d.k0 + 16 * kr) * d.N + d.n0 + 4 * nc;
#pragma unroll
    for (int i = 0; i < 16; ++i) v[i] = NT_LOAD((const GAS f32x4*)(src + (size_t)i * d.N));
#pragma unroll
    for (int i = 0; i < 4; ++i) g[i] = d.gk ? *(const GAS f32x4*)(d.gk + d.k0 + 16 * kr + 4 * i) : (f32x4){1.f, 1.f, 1.f, 1.f};
}
__device__ __forceinline__ void p0_store(const P0Item& d, const f32x4 (&v)[16], const f32x4 (&g)[4], LAS unsigned char* scr, int lane) {
    const int kr = lane >> 4, nc = lane & 15;
    if (d.f8s != 0.f) {
        const float sc = d.f8s;
#pragma unroll
        for (int q = 0; q < 4; ++q) { v4u w;
            w.x = pg8::pk4_fp8(v[0][q] * g[0][0] * sc, v[1][q] * g[0][1] * sc, v[2][q] * g[0][2] * sc, v[3][q] * g[0][3] * sc); w.y = pg8::pk4_fp8(v[4][q] * g[1][0] * sc, v[5][q] * g[1][1] * sc, v[6][q] * g[1][2] * sc, v[7][q] * g[1][3] * sc);
            w.z = pg8::pk4_fp8(v[8][q] * g[2][0] * sc, v[9][q] * g[2][1] * sc, v[10][q] * g[2][2] * sc, v[11][q] * g[2][3] * sc); w.w = pg8::pk4_fp8(v[12][q] * g[3][0] * sc, v[13][q] * g[3][1] * sc, v[14][q] * g[3][2] * sc, v[15][q] * g[3][3] * sc);
            *(LAS v4u*)(scr + (4 * nc + q) * 80 + 16 * kr) = w; }
        LDS_WAIT(); asm volatile("" ::: "memory");
        unsigned char* W8 = (unsigned char*)d.WT;
#pragma unroll
        for (int j = 0; j < 4; ++j) { const int p = lane + 64 * j, n = p >> 2, c = p & 3; const v4u x = *(const LAS v4u*)(scr + n * 80 + 16 * c);
            *(GAS v4u*)(W8 + (size_t)p0_rowmap(d.kind, d.add, d.n0 + n) * d.Kd + d.k0 + 16 * c) = x; }
        LDS_WAIT(); asm volatile("" ::: "memory");
        return;
    }
#pragma unroll
    for (int q = 0; q < 4; ++q) { v4u w0, w1;
        w0.x = cvtpk(v[0][q] * g[0][0], v[1][q] * g[0][1]); w0.y = cvtpk(v[2][q] * g[0][2], v[3][q] * g[0][3]); w0.z = cvtpk(v[4][q] * g[1][0], v[5][q] * g[1][1]); w0.w = cvtpk(v[6][q] * g[1][2], v[7][q] * g[1][3]);
        w1.x = cvtpk(v[8][q] * g[2][0], v[9][q] * g[2][1]); w1.y = cvtpk(v[10][q] * g[2][2], v[11][q] * g[2][3]); w1.z = cvtpk(v[12][q] * g[3][0], v[13][q] * g[3][1]); w1.w = cvtpk(v[14][q] * g[3][2], v[15][q] * g[3][3]);
        LAS unsigned char* p = scr + (4 * nc + q) * 144 + 32 * kr; *(LAS v4u*)p = w0; *(LAS v4u*)(p + 16) = w1; }
    LDS_WAIT(); asm volatile("" ::: "memory");
    const int c = lane & 7;
#pragma unroll
    for (int j = 0; j < 8; ++j) { const int n = (lane >> 3) + 8 * j; const v4u x = *(const LAS v4u*)(scr + n * 144 + 16 * c);
        *(GAS v4u*)(d.WT + (size_t)p0_rowmap(d.kind, d.add, d.n0 + n) * d.Kd + d.k0 + 8 * c) = x; }
    LDS_WAIT(); asm volatile("" ::: "memory");
}
template <int WHICH> __device__ __forceinline__ P0Item conv_decode(const Args& A, unsigned char* ws, int it) { if (WHICH == 0) return p0_decode(A, ws, it); if (WHICH == 1) return decode_w1(A, ws, it); return decode_w2(A, ws, it); }
template <int WHICH> __device__ __forceinline__ void conv_items(const Args& A, unsigned char* ws, int it0, int stride, int nitems, LAS unsigned char* sc8, int lane) {
    f32x4 va[16], ga[4], vb[16], gb[4]; P0Item da, db;
    int it = it0;
    if (it < nitems) { da = conv_decode<WHICH>(A, ws, it); p0_load(da, va, ga, lane); }
    while (it < nitems) {
        const bool hb_ = it + stride < nitems;
        if (hb_) { db = conv_decode<WHICH>(A, ws, it + stride); p0_load(db, vb, gb, lane); }
        p0_store(da, va, ga, sc8, lane);
        if (!hb_) break;
        const bool ha_ = it + 2 * stride < nitems;
        if (ha_) { da = conv_decode<WHICH>(A, ws, it + 2 * stride); p0_load(da, va, ga, lane); }
        p0_store(db, vb, gb, sc8, lane);
        if (!ha_) break;
        it += 2 * stride;
    }
}
struct ConvPre {
    struct Regs { f32x4 v[16], g[4]; };
    const Args* A; unsigned char* ws; int idx;
    __device__ __forceinline__ void issue(Regs& r, int lane) const { if (idx >= 0) { const P0Item d = decode_w1(*A, ws, idx); p0_load(d, r.v, r.g, lane); } }
    __device__ __forceinline__ void finish(const Regs& r, LAS unsigned char* scr, int lane) const { if (idx >= 0) { const P0Item d = decode_w1(*A, ws, idx); p0_store(d, r.v, r.g, scr, lane); } }
};
__device__ __forceinline__ void sincos_acc(float ang, float& s, float& c) {
    const double a = (double)ang, kq = __builtin_rint(a * 0.63661977236758134308), r = a - kq * 1.57079632679489661923;
    const float rf = (float)r, z = rf * rf;
    const float sp = rf + rf * z * (-1.6666654611e-1f + z * (8.3321608736e-3f + z * (-1.9515295891e-4f)));
    const float cp = 1.0f - 0.5f * z + z * z * (4.166664568298827e-2f + z * (-1.388731625493765e-3f + z * 2.443315711809948e-5f));
    const int q = ((int)kq) & 3;
    s = (q == 0) ? sp : (q == 1) ? cp : (q == 2) ? -sp : -cp;
    c = (q == 0) ? cp : (q == 1) ? -sp : (q == 2) ? -cp : sp;
}
__device__ __forceinline__ void p0_prologue(Frame& F, const Args& A) {
    LAS float* scr = (LAS float*)(F.lds + RING_OFF + F.wave * 16384);
    const int lane = otid() & 63;
    const int gw = F.vcu * NWAVES + F.wave, NGW = F.G * NWAVES;
    unsigned char* ws = F.ws;
    for (int r50_ = 0; r50_ < (PROBE_PHASE == 50 ? 2 : 1); ++r50_)
    { const float* x = A.in[0]; bf16* XB = (bf16*)(ws + WS_XB); float* rstd1 = (float*)(ws + WS_RSTD1);
      for (int m = gw; m < T; m += 2 * NGW) {
        const int m2 = (m + NGW < T) ? m + NGW : m;
        const GAS f32x4* xr = (const GAS f32x4*)(x + (size_t)m * D) + lane; const GAS f32x4* xr2 = (const GAS f32x4*)(x + (size_t)m2 * D) + lane;
        f32x4 v[4], w[4]; float s2 = 0.f, t2 = 0.f;
#pragma unroll
        for (int j = 0; j < 4; ++j) { v[j] = NT_LOAD(xr + 64 * j); w[j] = NT_LOAD(xr2 + 64 * j); }
#pragma unroll
        for (int j = 0; j < 4; ++j) { s2 += (v[j].x * v[j].x + v[j].y * v[j].y) + (v[j].z * v[j].z + v[j].w * v[j].w); t2 += (w[j].x * w[j].x + w[j].y * w[j].y) + (w[j].z * w[j].z + w[j].w * w[j].w); }
        const float rs = 1.0f / sqrtf(wave_sum(s2) * (1.f / D) + RMS_EPS), rt2 = 1.0f / sqrtf(wave_sum(t2) * (1.f / D) + RMS_EPS);
        GAS u32x2_t* o8 = (GAS u32x2_t*)(XB + (size_t)m * D) + lane; GAS u32x2_t* p8 = (GAS u32x2_t*)(XB + (size_t)m2 * D) + lane;
#pragma unroll
        for (int j = 0; j < 4; ++j) { o8[64 * j] = (u32x2_t){cvtpk(v[j].x, v[j].y), cvtpk(v[j].z, v[j].w)}; p8[64 * j] = (u32x2_t){cvtpk(w[j].x, w[j].y), cvtpk(w[j].z, w[j].w)}; }
        if (lane == 0) { rstd1[m] = rs; rstd1[m2] = rt2; }
      } }
    for (int r51_ = 0; r51_ < (PROBE_PHASE == 51 ? 2 : 1); ++r51_) conv_items<0>(A, ws, F.wave * F.G + F.vcu, NGW, P0_NITEMS, (LAS unsigned char*)scr, lane);
    const int gt = gw * 64 + olane(), NGT = NGW * 64;
    { bf16* WR = (bf16*)(ws + WS_WR); const float* g = A.in[17]; const float* wg = A.in[18]; const float* we = A.in[20];
      for (int i = gt; i < 48 * 1024; i += NGT) { const int j = i >> 10, k = i & 1023; float v = 0.f; if (j < 32) v = we[k * 32 + j] * g[k]; else if (j < 36) v = wg[k * 4 + (j - 32)] * g[k]; WR[i] = (bf16)f2bf(v); } }
    { bf16* SGW = (bf16*)(ws + WS_SGW); const float* w = A.in[13];
      for (int i = gt; i < 4 * 128 * 128; i += NGT) { const int t = (i >> 7) & 127, s = i & 127; SGW[i] = (bf16)f2bf(s <= t ? w[i] : 0.f); }
      float* RW = (float*)(ws + WS_SGW + 131072);
      for (int i = gw; i < 4 * 128; i += NGW) { const int t = i & 127, l_ = olane(); const float a = wave_sum((l_ <= t ? w[i * 128 + l_] : 0.f) + (l_ + 64 <= t ? w[i * 128 + 64 + l_] : 0.f)); if (l_ == 0) RW[i] = a; } }
    { float* rope = (float*)(ws + WS_ROPE); const int* pos = (const int*)A.in[1];
      for (int i = gt; i < T * 8; i += NGT) { const int m = i >> 3, j = i & 7; const float ang = (float)pos[m] * A.ifq.f[j]; float s, c; sincos_acc(ang, s, c); rope[m * 16 + j] = c; rope[m * 16 + 8 + j] = s; } }
}

__device__ __forceinline__ void attn_combine(long tok0, int h, const bf16* Oraw, bf16* mix, const float* g, float lam) {
    const int lane = olane();
    asm volatile("s_waitcnt vmcnt(0)" ::: "memory");
    const int ch = lane & 7;
    f32x4 g0a = *(const f32x4*)(g + ch * 8), g0b = *(const f32x4*)(g + ch * 8 + 4), g1a = *(const f32x4*)(g + 64 + ch * 8), g1b = *(const f32x4*)(g + 64 + ch * 8 + 4);
#pragma unroll
    for (int i = 0; i < 4; ++i) {
        const long tok = tok0 + i * 8 + (lane >> 3);
        const bf16* src = Oraw + tok * 1024 + h * 256 + ch * 8;
        const v4u a00 = *(const GAS v4u*)(src), a01 = *(const GAS v4u*)(src + 64), a10 = *(const GAS v4u*)(src + 128), a11 = *(const GAS v4u*)(src + 192);
        float d0[8], d1[8]; float ss = 0.f;
#pragma unroll
        for (int j = 0; j < 4; ++j) {
            d0[2 * j] = bflo(a00[j]) - lam * bflo(a10[j]); d0[2 * j + 1] = bfhi(a00[j]) - lam * bfhi(a10[j]);
            d1[2 * j] = bflo(a01[j]) - lam * bflo(a11[j]); d1[2 * j + 1] = bfhi(a01[j]) - lam * bfhi(a11[j]);
            ss += d0[2 * j] * d0[2 * j] + d0[2 * j + 1] * d0[2 * j + 1] + d1[2 * j] * d1[2 * j] + d1[2 * j + 1] * d1[2 * j + 1]; }
        ss += sxor<1>(ss); ss += sxor<2>(ss); ss += sxor<4>(ss);
        const float rn = (1.0f - LAMBDA_INIT) / sqrtf(ss * (1.0f / 128.0f) + RMS_EPS);
        v4u o0, o1;
        o0.x = cvtpk(d0[0] * rn * g0a[0], d0[1] * rn * g0a[1]); o0.y = cvtpk(d0[2] * rn * g0a[2], d0[3] * rn * g0a[3]); o0.z = cvtpk(d0[4] * rn * g0b[0], d0[5] * rn * g0b[1]); o0.w = cvtpk(d0[6] * rn * g0b[2], d0[7] * rn * g0b[3]);
        o1.x = cvtpk(d1[0] * rn * g1a[0], d1[1] * rn * g1a[1]); o1.y = cvtpk(d1[2] * rn * g1a[2], d1[3] * rn * g1a[3]); o1.z = cvtpk(d1[4] * rn * g1b[0], d1[5] * rn * g1b[1]); o1.w = cvtpk(d1[6] * rn * g1b[2], d1[7] * rn * g1b[3]);
        bf16* dst = mix + tok * 1024 + h * 128 + ch * 8;
        *(GAS v4u*)dst = o0; *(GAS v4u*)(dst + 64) = o1;
    }
}
struct SguPre { f32x4 st[4]; v4u sv[4]; v4u uw[4]; };
__device__ __forceinline__ void sgu_prefetch(SguPre& P, unsigned char* ws, int u, int tid) {
    const int b = u >> 6, c = (u >> 2) & 15, g = u & 3, s = tid >> 2, seg = tid & 3; const long tok = (long)b * SEQ + c * 128 + s;
    { const int lane_ = tid & 63, wid_ = tid >> 6; const bf16* up = (const bf16*)(ws + WS_SU) + ((long)b * SEQ + c * 128 + 16 * wid_ + (lane_ & 15)) * 512 + g * 128 + 8 * (lane_ >> 4);
#pragma unroll
      for (int a = 0; a < 4; ++a) P.uw[a] = *(const GAS v4u*)(up + 32 * a); }
    const float* st = (const float*)(ws + WS_SVST) + tok * 16; const bf16* src = (const bf16*)(ws + WS_SV) + tok * 512 + g * 128 + seg * 8;
#pragma unroll
    for (int i = 0; i < 4; ++i) P.st[i] = *(const GAS f32x4*)(st + 4 * i);
#pragma unroll
    for (int j = 0; j < 4; ++j) P.sv[j] = *(const GAS v4u*)(src + 32 * j);
}
__device__ __forceinline__ void p2_sgu(Frame& F, const Args& A) {
    constexpr int VP = 136;
    LAS unsigned short* vnT = (LAS unsigned short*)(F.lds + RING_OFF);
    unsigned char* ws = F.ws;
    const int tid = otid(), lane = tid & 63, wid = F.wave, fr = lane & 15, fq = lane >> 4;
    const int NU = BATCH * 16 * 4;
    const int gs_ = F.gr < 4 ? F.gr : 7 - F.gr, gb_ = 2 * F.gx + (F.gr >= 4 ? 1 : 0);
    auto unit_of = [&](int k) -> int { if (!F.grp) return F.vcu + k * F.G; const int c = k < 2 ? 2 * gs_ + k : 14 - 2 * gs_ + (k - 2); return (gb_ << 6) | (c << 2) | F.gp; };
    int uk = 0;
    int u = unit_of(0); if (u >= NU) return;
    SguPre P; sgu_prefetch(P, ws, u, tid);
    const int t = 16 * wid + fr, nks = (wid >> 1) + 1;
    int gcur = -1; f32x4 ga[8], cb[8]; bf16x8 wf[4];
    for (;;) {
        const int b = u >> 6, c = (u >> 2) & 15, g = u & 3;
        if (g != gcur) { gcur = g;
            const float* lg = A.in[11] + g * 128 + 8 * fq; const float* lb = A.in[12] + g * 128 + 8 * fq;
            const float bs = A.in[14][g * 128 + t], rw = ((const float*)(ws + WS_SGW + 131072))[g * 128 + t];
#pragma unroll
            for (int i = 0; i < 8; ++i) { const int co = 32 * (i >> 1) + 4 * (i & 1); ga[i] = *(const GAS f32x4*)(lg + co); cb[i] = *(const GAS f32x4*)(lb + co) * rw + bs; }
            const bf16* Wg = (const bf16*)(ws + WS_SGW) + g * 16384 + t * 128 + 8 * fq;
#pragma unroll
            for (int ks = 0; ks < 4; ++ks) wf[ks] = *(const GAS bf16x8*)(Wg + 32 * (ks < nks ? ks : 0)); }
        { const int s = tid >> 2, seg = tid & 3; float sum = 0.f, sq = 0.f;
#pragma unroll
          for (int i = 0; i < 4; ++i) { sum += P.st[i].x + P.st[i].z; sq += P.st[i].y + P.st[i].w; }
          const float mean = sum * (1.0f / 512.0f), var = sq * (1.0f / 512.0f) - mean * mean, rstd = 1.0f / sqrtf(var + RMS_EPS);
#pragma unroll
          for (int j = 0; j < 4; ++j)
#pragma unroll
            for (int e = 0; e < 8; ++e) { const unsigned w = P.sv[j][e >> 1]; const float xv = (e & 1) ? bfhi(w) : bflo(w); const int d = 32 * j + 8 * seg + e;
                vnT[(32 * j + 16 * (e >> 2) + 4 * seg + (e & 3)) * VP + s] = (unsigned short)f2bf((xv - mean) * rstd); (void)d; } }
        const long tok = (long)b * SEQ + c * 128 + t;
        u32x2_t uw[8];
#pragma unroll
        for (int a = 0; a < 4; ++a) { uw[2 * a] = (u32x2_t){P.uw[a].x, P.uw[a].y}; uw[2 * a + 1] = (u32x2_t){P.uw[a].z, P.uw[a].w}; }
        __syncthreads();
        const int un = unit_of(uk + 1); const bool more = F.grp ? (uk + 1 < 4) : (un < NU);
        if (more) sgu_prefetch(P, ws, un, tid);
        f32x4 acc[8];
#pragma unroll
        for (int i = 0; i < 8; ++i) acc[i] = (f32x4){0.f, 0.f, 0.f, 0.f};
#pragma unroll
        for (int ks = 0; ks < 4; ++ks) if (ks < nks) {
#pragma unroll
            for (int i = 0; i < 8; ++i) { const bf16x8 xf = *(const LAS bf16x8*)(vnT + (16 * i + fr) * VP + 32 * ks + 8 * fq);
                acc[i] = __builtin_amdgcn_mfma_f32_16x16x32_bf16(xf, wf[ks], acc[i], 0, 0, 0); } }
        const float* og = A.in[15] + g * 128 + 8 * fq; f32x4 gv[8];
#pragma unroll
        for (int i = 0; i < 8; ++i) gv[i] = *(const GAS f32x4*)(og + 32 * (i >> 1) + 4 * (i & 1));
        float sg[8][4]; float ss = 0.f;
#pragma unroll
        for (int i = 0; i < 8; ++i) {
            const pg8::f32x2 u01 = pg8::gelu_pk((pg8::f32x2){bflo(uw[i].x), bfhi(uw[i].x)}), u23 = pg8::gelu_pk((pg8::f32x2){bflo(uw[i].y), bfhi(uw[i].y)});
            sg[i][0] = u01.x * (ga[i].x * acc[i][0] + cb[i].x); sg[i][1] = u01.y * (ga[i].y * acc[i][1] + cb[i].y);
            sg[i][2] = u23.x * (ga[i].z * acc[i][2] + cb[i].z); sg[i][3] = u23.y * (ga[i].w * acc[i][3] + cb[i].w);
            ss += (sg[i][0] * sg[i][0] + sg[i][1] * sg[i][1]) + (sg[i][2] * sg[i][2] + sg[i][3] * sg[i][3]); }
        ss += sxor<16>(ss); ss = sum32(ss);
        const float rn = 1.0f / sqrtf(ss * (1.0f / 128.0f) + RMS_EPS);
        bf16* mp = (bf16*)(ws + WS_MIX) + tok * 1024 + 512 + g * 128 + 8 * fq;
#pragma unroll
        for (int a = 0; a < 4; ++a) { const int i0 = 2 * a, i1 = 2 * a + 1;
            *(GAS v4u*)(mp + 32 * a) = (v4u){cvtpk(sg[i0][0] * rn * gv[i0].x, sg[i0][1] * rn * gv[i0].y), cvtpk(sg[i0][2] * rn * gv[i0].z, sg[i0][3] * rn * gv[i0].w),
                                             cvtpk(sg[i1][0] * rn * gv[i1].x, sg[i1][1] * rn * gv[i1].y), cvtpk(sg[i1][2] * rn * gv[i1].z, sg[i1][3] * rn * gv[i1].w)}; }
        __syncthreads();
        if (!more) break;
        u = un; ++uk;
    }
}
struct NoPost { struct Regs {}; __device__ __forceinline__ void prefetch(Regs&, int) const {} __device__ __forceinline__ void run(const Regs&, int, int) const {} };
__device__ __forceinline__ void p2_mixers(Frame& F, const Args& A, const int part  ) {
    unsigned char* ws = F.ws;
    const int l0 = otid() & 63;
    const float lam = __builtin_bit_cast(float, __builtin_amdgcn_readfirstlane(__builtin_bit_cast(int, expf(wave_sum(A.in[6][l0] * A.in[7][l0])) - expf(wave_sum(A.in[8][l0] * A.in[9][l0])) + LAMBDA_INIT)));
    const attn_body::bf16* Q = (const attn_body::bf16*)(ws + WS_Q); const attn_body::bf16* Kt = (const attn_body::bf16*)(ws + WS_K); const attn_body::bf16* V = (const attn_body::bf16*)(ws + WS_V);
    attn_body::bf16* Oraw = (attn_body::bf16*)(ws + WS_HB);
    const bool sgu_first = F.grp && (F.gp & 1);
    if (sgu_first) p2_sgu(F, A);
    if (part != 2)
    for (int rA_ = 0; rA_ < (PROBE_PHASE == 20 ? 2 : 1); ++rA_)
    for (int it = F.vcu; it < 256; it += F.G) {
        int bh = it >> 2, s = it & 3, b = bh >> 2, h = bh & 3;
        if (F.grp) { s = F.gr < 4 ? F.gr : 7 - F.gr; b = 2 * F.gx + (F.gr >= 4 ? 1 : 0); h = F.gp; }
        for (int j = 0; j < 4; ++j) {
            const int qb = (j < 2) ? 7 - s : s, m = j & 1;
            const int cidx = ((it * 4 + j) * NWAVES) + F.wave; const ConvPre pre{&A, ws, cidx < W1_NITEMS ? cidx : -1};
            const NoPost post{};
            attn_body::attn_unit2(F.wave, (long)b * SEQ, qb, Q + (h * 2 + m) * 64, Kt + (h * 2 + m) * 64, V + h * 128, Oraw + (h * 2 + m) * 128, (char*)(F.lds + RING_OFF), pre, post);
            if (m == 1) attn_combine((long)b * SEQ + qb * 256 + F.wave * 32, h, (const bf16*)(ws + WS_HB), (bf16*)(ws + WS_MIX), A.in[10], lam);
        }
    }
    if (part != 1 && !sgu_first)
    for (int rS_ = 0; rS_ < (PROBE_PHASE == 21 ? 2 : 1); ++rS_) p2_sgu(F, A);
}

__device__ __forceinline__ void p4_router(Frame& F, const Args& A) {
    unsigned char* ws = F.ws;
    const int tid = otid(), lane = tid & 63, wid = F.wave, fr = lane & 15, fq = lane >> 4;
    constexpr int WPITCH = 2064;
    LAS unsigned char* wl = F.lds + RING_OFF;
    LAS float* lg = (LAS float*)(F.lds + RING_OFF + 102400) + wid * (16 * 49);
    LAS unsigned* hist = (LAS unsigned*)(F.lds + L_HIST); LAS unsigned* base = (LAS unsigned*)(F.lds + L_BASE);
    const bf16* HB = (const bf16*)(ws + WS_HB); const bf16* WR = (const bf16*)(ws + WS_WR);
    const float* hst = (const float*)(ws + WS_HST); float* rstd2 = (float*)(ws + WS_RSTD2);
    int* elist = (int*)(ws + WS_ELIST); f32x2_t* evals = (f32x2_t*)(ws + WS_EVALS);
    bool staged = false;
    for (int blk = F.grp ? 2 * (16 * F.gx + 8 * (F.gp >> 1) + F.gr) + (F.gp & 1) : F.vcu; blk < T / 128; blk += F.grp ? T : F.G) {
        if (tid < 32) hist[tid] = 0u;
        __syncthreads();
        const int tok0 = blk * 128 + wid * 16;
        f32x4 acc[3];
        for (int rr_ = 0; rr_ < (PROBE_PHASE == 4 ? 2 : 1); ++rr_) {
#pragma unroll
        for (int n = 0; n < 3; ++n) acc[n] = (f32x4){0.f, 0.f, 0.f, 0.f};
        const bf16* hp = HB + (size_t)(tok0 + fr) * 1024 + 16 * fq;
        bf16x8 y[32];
#pragma unroll
        for (int ks = 0; ks < 32; ++ks) y[ks] = *(const GAS bf16x8*)(hp + 64 * (ks >> 1) + 8 * (ks & 1));
        if (!staged) { staged = true;
            for (int p = tid; p < 48 * 128; p += NWAVES * 64) { const int row = p >> 7, c = p & 127; *(LAS v4u*)(wl + row * WPITCH + c * 16) = *(const GAS v4u*)(WR + row * 1024 + c * 8); }
            __syncthreads(); }
        { unsigned char* h8p = ws + WS_H8 + (size_t)(tok0 + fr) * 1024 + 16 * fq;
#pragma unroll
          for (int t = 0; t < 16; ++t) { const v4u w = __builtin_bit_cast(v4u, y[2 * t]), z = __builtin_bit_cast(v4u, y[2 * t + 1]);
              *(GAS v4u*)(h8p + 64 * t) = (v4u){pg8::pk4_fp8(bflo(w.x) * pg8::H8_SCALE, bfhi(w.x) * pg8::H8_SCALE, bflo(w.y) * pg8::H8_SCALE, bfhi(w.y) * pg8::H8_SCALE),
                                                pg8::pk4_fp8(bflo(w.z) * pg8::H8_SCALE, bfhi(w.z) * pg8::H8_SCALE, bflo(w.w) * pg8::H8_SCALE, bfhi(w.w) * pg8::H8_SCALE),
                                                pg8::pk4_fp8(bflo(z.x) * pg8::H8_SCALE, bfhi(z.x) * pg8::H8_SCALE, bflo(z.y) * pg8::H8_SCALE, bfhi(z.y) * pg8::H8_SCALE),
                                                pg8::pk4_fp8(bflo(z.z) * pg8::H8_SCALE, bfhi(z.z) * pg8::H8_SCALE, bflo(z.w) * pg8::H8_SCALE, bfhi(z.w) * pg8::H8_SCALE)}; } }
        const LAS unsigned char* wp = wl + fr * WPITCH + 32 * fq;
#pragma unroll
        for (int ks = 0; ks < 32; ++ks) {
#pragma unroll
            for (int n = 0; n < 3; ++n) { const bf16x8 xf = *(const LAS bf16x8*)(wp + n * 16 * WPITCH + 128 * (ks >> 1) + 16 * (ks & 1)); acc[n] = __builtin_amdgcn_mfma_f32_16x16x32_bf16(xf, y[ks], acc[n], 0, 0, 0); }
        }
        asm volatile("" ::: "memory"); }
        float rs; { const float* hs = hst + (size_t)(tok0 + fr) * 16; float s = 0.f;
#pragma unroll
            for (int i = 0; i < 4; ++i) { const f32x4 p = *(const GAS f32x4*)(hs + 4 * i); s += (p.x + p.y) + (p.z + p.w); }
            rs = 1.0f / sqrtf(s * (1.0f / 1024.0f) + RMS_EPS); if (fq == 0) rstd2[tok0 + fr] = rs; }
#pragma unroll
        for (int n = 0; n < 3; ++n)
#pragma unroll
            for (int r = 0; r < 4; ++r) { const int j = 16 * n + 4 * fq + r; float bias = 0.f; if (j < 32) bias = A.in[21][j]; else if (j < 36) bias = A.in[19][j - 32];
                lg[fr * 49 + j] = acc[n][r] * rs + bias; }
        LDS_WAIT(); asm volatile("" ::: "memory");
        int e1 = 0, e2 = 0; unsigned l1 = 0, l2 = 0; float g1 = 0.f, g2 = 0.f;
        if (lane < 16) {
            const LAS float* L = lg + lane * 49;
            float gm = L[32]; int grp = 0;
#pragma unroll
            for (int i = 1; i < 4; ++i) { const float v = L[32 + i]; if (v > gm) { gm = v; grp = i; } }
            float Z = 0.f;
#pragma unroll
            for (int i = 0; i < 4; ++i) Z += expf(L[32 + i] - gm);
            const float pg = 1.0f / Z;
            float el[8];
#pragma unroll
            for (int i = 0; i < 8; ++i) el[i] = L[grp * 8 + i];
            float v1 = el[0]; int i1 = 0;
#pragma unroll
            for (int i = 1; i < 8; ++i) if (el[i] > v1) { v1 = el[i]; i1 = i; }
            float v2 = -INFINITY; int i2 = 0;
#pragma unroll
            for (int i = 0; i < 8; ++i) if (i != i1 && el[i] > v2) { v2 = el[i]; i2 = i; }
            const float s1 = 1.0f / (1.0f + expf(v2 - v1));
            g1 = pg * s1; g2 = pg * (1.0f - s1); e1 = grp * 8 + i1; e2 = grp * 8 + i2;
            l1 = __hip_atomic_fetch_add(&hist[e1], 1u, __ATOMIC_RELAXED, __HIP_MEMORY_SCOPE_WORKGROUP); l2 = __hip_atomic_fetch_add(&hist[e2], 1u, __ATOMIC_RELAXED, __HIP_MEMORY_SCOPE_WORKGROUP);
        }
        __syncthreads();
        if (tid < 32) base[tid] = __hip_atomic_fetch_add((unsigned*)(F.ctl + CW_CNT + 64 * tid), hist[tid], __ATOMIC_RELAXED, __HIP_MEMORY_SCOPE_AGENT);
        __syncthreads();
        if (lane < 16) { const int tok = tok0 + lane;
            const size_t i1 = (size_t)e1 * ECAP + base[e1] + l1, i2 = (size_t)e2 * ECAP + base[e2] + l2;
            elist[i1] = 2 * tok; evals[i1] = (f32x2_t){rs, g1}; elist[i2] = 2 * tok + 1; evals[i2] = (f32x2_t){rs, g2}; }
        __syncthreads();
    }
}

__device__ __forceinline__ void moe_tables(Frame& F, int reps) {
    LAS int* ts = (LAS int*)(F.lds + L_TSTART); LAS int* rs = (LAS int*)(F.lds + L_RSTART); LAS int* cn = (LAS int*)(F.lds + L_CNT); LAS int* ul = (LAS int*)(F.lds + L_ULIST);
    const int tid = otid();
    if (tid < 32) cn[tid] = (int)__hip_atomic_load((unsigned*)(F.ctl + CW_CNT + 64 * tid), __ATOMIC_RELAXED, __HIP_MEMORY_SCOPE_AGENT);
    __syncthreads();
    if (tid == 0) { int a = 0, b = 0; for (int e = 0; e < NE; ++e) { ts[e] = a; rs[e] = b; a += (cn[e] + 255) >> 8; b += cn[e]; } ts[NE] = a; rs[NE] = b; }
    __syncthreads();
    if (tid < 16) { const int total = ts[NE] * 4; int L = tid * F.G + F.vcu; int e = -1, rt = 0, ct = 0;
        if (L < total * reps) { if (L >= total) L -= total;
            const int rtg = L >> 2; ct = L & 3; e = 0; for (int k = 1; k < NE; ++k) if (rtg >= ts[k]) e = k; rt = rtg - ts[e]; }
        ul[tid * 8 + 0] = e; ul[tid * 8 + 1] = rt; ul[tid * 8 + 2] = ct; ul[tid * 8 + 3] = e >= 0 ? min(256, cn[e] - rt * 256) : 0; ul[tid * 8 + 4] = e >= 0 ? rs[e] + rt * 256 : 0; }
    __syncthreads();
}
template <int VS> struct MoeOrder {
    const LAS int* ul; const int* elist; const float* evals; const LAS unsigned char* rowtab;
    static constexpr bool ROWREC = true; static constexpr int VALSEL = VS;
    __device__ __forceinline__ bool next(int i, pg8::Unit& u) const {
        if (i >= 16) return false;
        const int e = __builtin_amdgcn_readfirstlane(ul[i * 8 + 0]); if (e < 0) return false;
        const int rt = __builtin_amdgcn_readfirstlane(ul[i * 8 + 1]), ct = __builtin_amdgcn_readfirstlane(ul[i * 8 + 2]);
        u.e = e; u.pm = rt; u.pn = ct; u.nvalid = __builtin_amdgcn_readfirstlane(ul[i * 8 + 3]); u.arow = __builtin_amdgcn_readfirstlane(ul[i * 8 + 4]);
        u.lst = elist + (size_t)e * ECAP + rt * 256; u.vals = evals + ((size_t)e * ECAP + rt * 256) * 2; u.brow = e * 1024 + ct * 256; return true;
    }
};

__device__ __forceinline__ void p7_combine(Frame& F) {
    const int gw = F.vcu * NWAVES + F.wave, NGW = F.G * NWAVES, lane = olane();
    const unsigned char* Y = F.ws + WS_Y; const bf16* HB = (const bf16*)(F.ws + WS_HB);
    typedef float f32x2v __attribute__((ext_vector_type(2)));
    for (int m = gw; m < T; m += NGW) {
        GAS f32x4* o = (GAS f32x4*)(F.out + (size_t)m * D) + lane;
        const GAS u32x2_t* hp = (const GAS u32x2_t*)(HB + (size_t)m * D) + lane;
        const GAS unsigned* y0 = (const GAS unsigned*)(Y + (size_t)(2 * m) * D) + lane; const GAS unsigned* y1 = (const GAS unsigned*)(Y + (size_t)(2 * m + 1) * D) + lane;
        u32x2_t h[4]; unsigned a[4], b[4];
#pragma unroll
        for (int j = 0; j < 4; ++j) { h[j] = NT_LOAD(hp + 64 * j); a[j] = NT_LOAD(y0 + 64 * j); b[j] = NT_LOAD(y1 + 64 * j); }
#pragma unroll
        for (int j = 0; j < 4; ++j) {
            const f32x2v a0 = __builtin_amdgcn_cvt_pk_f32_fp8((int)a[j], false), a1 = __builtin_amdgcn_cvt_pk_f32_fp8((int)a[j], true);
            const f32x2v b0 = __builtin_amdgcn_cvt_pk_f32_fp8((int)b[j], false), b1 = __builtin_amdgcn_cvt_pk_f32_fp8((int)b[j], true);
            f32x4 r; r.x = bflo(h[j].x) + (a0.x + b0.x) * (1.0f / pg8::Y8_SCALE); r.y = bfhi(h[j].x) + (a0.y + b0.y) * (1.0f / pg8::Y8_SCALE);
            r.z = bflo(h[j].y) + (a1.x + b1.x) * (1.0f / pg8::Y8_SCALE); r.w = bfhi(h[j].y) + (a1.y + b1.y) * (1.0f / pg8::Y8_SCALE);
            NT_STORE(r, o + 64 * j); }
    }
}

__global__ void __launch_bounds__(NWAVES * 64, 2) hymba_fwd(Args args) {
    extern __shared__ __attribute__((aligned(16))) unsigned char lds[];
    Frame F;
    F.lds = (LAS unsigned char*)lds;
    F.wave = __builtin_amdgcn_readfirstlane((int)threadIdx.x >> 6);
    F.G = gridDim.x; { const int bx = blockIdx.x; F.vcu = (F.G % 8 == 0) ? (bx % 8) * (F.G / 8) + bx / 8 : bx; }
    unsigned char* ws = args.ws; F.ws = ws; F.out = args.out;
    F.ctl = (gu32*)(ws + WS_CTL);
    F.grp = (N_LAUNCHES == 1 && F.G == 256 && PROBE_PHASE < 0) ? 1 : 0; F.gx = (int)blockIdx.x & 7; F.gr = ((int)blockIdx.x >> 3) & 7; F.gp = (int)blockIdx.x >> 6;
    for (int u = threadIdx.x; u < (LDS_BYTES - LCTL_OFF) / 4; u += NWAVES * 64) ((LAS unsigned*)(F.lds + LCTL_OFF))[u] = 0u;
    __syncthreads();
    XcdBarrier bar; bar.bar = (unsigned*)(F.ctl + CW_BAR); bar.x = 0; bar.st = nullptr;
    if (N_LAUNCHES == 1) bar = xcd_barrier_post((unsigned*)(F.ctl + CW_BAR), (volatile LAS unsigned*)(F.lds + L_MISC), threadIdx.x == 0);
    if (F.grp && threadIdx.x == 0) __hip_atomic_store((unsigned*)(F.ctl + CW_XID + blockIdx.x), xb_xcc_id() + 1u, __ATOMIC_RELAXED, __HIP_MEMORY_SCOPE_AGENT);
    const int lo = args.ph_lo, hi = args.ph_hi;
#define IN(k) (lo <= (k) && (k) < hi)
#ifndef PROBE_PHASE
#define PROBE_PHASE -1
#endif
#ifndef PROBE_MODE
#define PROBE_MODE 0
#endif
#define REPS(k) for (int rep_ = 0; rep_ < ((k) == PROBE_PHASE ? 2 : 1); ++rep_)
#define SEAM(k) do { if (IN(k) && IN((k) + 1)) { if (PROBE_PHASE == 32) { asm volatile("s_waitcnt vmcnt(0)" ::: "memory"); if (F.wave == 0 && olane() == 0) __builtin_amdgcn_fence(__ATOMIC_RELEASE, "agent"); } xcd_barrier(bar, F.wave == 0 && olane() == 0); if (PROBE_PHASE == 30) { xcd_barrier(bar, F.wave == 0 && olane() == 0); xcd_barrier(bar, F.wave == 0 && olane() == 0); } } } while (0)

    if (IN(0)) REPS(0) { p0_prologue(F, args); } SEAM(0);
    unsigned* gword = (unsigned*)(F.ctl + CW_GRP + 64 * (4 * F.gx + (F.gr < 4 ? F.gr : 7 - F.gr)));
    unsigned* xword = (unsigned*)(F.ctl + CW_GRP + 64 * (32 + F.gx));
    if (F.grp && threadIdx.x == 0) { const unsigned mine = xb_xcc_id() + 1u; unsigned same8 = 1u, same32 = 1u; const int s_ = F.gr < 4 ? F.gr : 7 - F.gr;
        for (int k = 0; k < 32; ++k) { const int r_ = k & 7, p_ = k >> 3; const bool eq = xb_ld((unsigned*)(F.ctl + CW_XID + F.gx + 8 * r_ + 64 * p_)) == mine;
            if (!eq) { same32 = 0u; if (r_ == s_ || r_ == 7 - s_) same8 = 0u; } }
        ((volatile LAS unsigned*)(F.lds + L_MISC))[4] = same8; ((volatile LAS unsigned*)(F.lds + L_MISC))[5] = same32; }
#ifndef STAG1
#define STAG1 0
#endif
#ifndef STAG3
#define STAG3 0
#endif
#define STAGGER(n) do { if (F.vcu & 1) { for (int s_ = 0; s_ < (n); ++s_) __builtin_amdgcn_s_sleep(20); } } while (0)
    if (IN(1)) REPS(1) {
        STAGGER(STAG1);
        pg8::Gemm g{(const pg8::bf16_t*)(ws + WS_XB), (const pg8::bf16_t*)(ws + WS_WIN), D};
        pg8::StaticOrder S; S.init(T, INC, F.G, (int)blockIdx.x);
        pg8::EpiInProj E{(pg8::bf16_t*)(ws + WS_Q), (pg8::bf16_t*)(ws + WS_K), (pg8::bf16_t*)(ws + WS_V), (pg8::bf16_t*)(ws + WS_SU), (pg8::bf16_t*)(ws + WS_SV),
                         (const float*)(ws + WS_RSTD1), (const float*)(ws + WS_ROPE), args.in[4], args.in[5], (float*)(ws + WS_SVST), (PROBE_PHASE == 1 && rep_ == 1) ? PROBE_MODE : 0};
        pg8::gemm_phase<pg8::EpiInProj, pg8::StaticOrder, false>(F.lds + RING_OFF, g, S, E, F.wave);
    } if (F.grp) { grp_barrier((unsigned*)(F.ctl + CW_BAR), xword, 32u, ((volatile LAS unsigned*)(F.lds + L_MISC))[5] != 0u, threadIdx.x == 0); } else SEAM(1);
#define GSEAM(k, tgt) do { if (F.grp) { grp_barrier((unsigned*)(F.ctl + CW_BAR), gword, (tgt), ((volatile LAS unsigned*)(F.lds + L_MISC))[4] != 0u, threadIdx.x == 0); } else SEAM(k); } while (0)
    if (IN(2)) REPS(2) {
        if (PROBE_PHASE == 31) { p2_mixers(F, args, 1); xcd_barrier(bar, F.wave == 0 && olane() == 0); p2_mixers(F, args, 2); }
        else p2_mixers(F, args, 0);
    } GSEAM(2, 8u);
    if (IN(3)) REPS(3) {
        STAGGER(STAG3);
        pg8::Gemm g{(const pg8::bf16_t*)(ws + WS_MIX), (const pg8::bf16_t*)(ws + WS_WOUT), D};
        pg8::StaticOrder S; S.init(T, D, F.G, (int)blockIdx.x);
        pg8::EpiOutProj E{(const pg8::bf16_t*)(ws + WS_XB), (pg8::bf16_t*)(ws + WS_HB), (float*)(ws + WS_HST)};
        pg8::gemm_phase<pg8::EpiOutProj, pg8::StaticOrder, false>(F.lds + RING_OFF, g, S, E, F.wave);
    } GSEAM(3, 16u);
    if (IN(4)) { p4_router(F, args); } SEAM(4);
    if (IN(5)) {
        moe_tables(F, PROBE_PHASE == 5 ? 2 : 1);
        pg8::Gemm g{(const pg8::bf16_t*)(ws + WS_H8), (const pg8::bf16_t*)(ws + WS_W1), D / 2};
        MoeOrder<0> S{(const LAS int*)(F.lds + L_ULIST), (const int*)(ws + WS_ELIST), (const float*)(ws + WS_EVALS), F.lds + L_ROWTAB};
        pg8::EpiMoeUp E{ws + WS_XB, F.lds + L_ROWTAB};
        pg8::gemm_phase<pg8::EpiMoeUp, MoeOrder<0>, true, true>(F.lds + RING_OFF, g, S, E, F.wave);
        { const int total = __builtin_amdgcn_readfirstlane(((const LAS int*)(F.lds + L_TSTART))[NE]) * 4, rem = total % F.G;
          if (F.vcu >= rem) conv_items<2>(args, ws, (F.vcu - rem) * NWAVES + F.wave, (F.G - rem) * NWAVES, W2_NITEMS, (LAS unsigned char*)(F.lds + RING_OFF + F.wave * 16384), olane()); }
    } SEAM(5);
    if (IN(6)) REPS(6) {
        moe_tables(F, 1);
        pg8::Gemm g{(const pg8::bf16_t*)(ws + WS_XB), (const pg8::bf16_t*)(ws + WS_W2), FF / 2};
        MoeOrder<1> S{(const LAS int*)(F.lds + L_ULIST), (const int*)(ws + WS_ELIST), (const float*)(ws + WS_EVALS), F.lds + L_ROWTAB};
        pg8::EpiMoeDown E{ws + WS_Y, F.lds + L_ROWTAB, (PROBE_PHASE == 6 && rep_ == 1) ? PROBE_MODE : 0};
        pg8::gemm_phase<pg8::EpiMoeDown, MoeOrder<1>, false, true>(F.lds + RING_OFF, g, S, E, F.wave);
    } SEAM(6);
    if (IN(7)) REPS(7) { p7_combine(F); }
#undef IN
#undef SEAM
}

extern "C" void kernel_launch(void* const* d_in, const int* in_sizes, int n_in, void* d_out, int out_size, void* d_ws, size_t ws_size, hipStream_t stream) {
    static int grid = 0;
    if (grid == 0) {
        if (n_in != 25 || in_sizes[0] != T * D || out_size != T * D || ws_size < WS_END) { fprintf(stderr, "kernel_launch: shape/workspace mismatch (n_in %d, in0 %d, out %d, ws %zu); nothing launched\n", n_in, n_in > 0 ? in_sizes[0] : -1, out_size, ws_size); grid = -1; return; }
        int dev = 0, cus = 0, per_cu = 0;
        if (hipGetDevice(&dev) != hipSuccess || hipDeviceGetAttribute(&cus, hipDeviceAttributeMultiprocessorCount, dev) != hipSuccess) { grid = -1; return; }
        if (hipFuncSetAttribute((const void*)hymba_fwd, hipFuncAttributeMaxDynamicSharedMemorySize, LDS_BYTES) != hipSuccess) { fprintf(stderr, "kernel_launch: hipFuncSetAttribute failed\n"); grid = -1; return; }
        if (hipOccupancyMaxActiveBlocksPerMultiprocessor(&per_cu, (const void*)hymba_fwd, NWAVES * 64, LDS_BYTES) != hipSuccess || per_cu < 1) { fprintf(stderr, "kernel_launch: occupancy query reports %d workgroups per CU\n", per_cu); }
        (void)hipGetLastError();
        grid = cus;
        if (grid > 256) grid = 256;
    }
    if (grid < 0) return;
#if PROBE_PHASE == 99
    for (int pass_ = 0; pass_ < 2; ++pass_) {
#endif
    if (hipMemsetAsync((char*)d_ws + WS_CTL, 0, CTL_ZERO_BYTES, stream) != hipSuccess) return;
    Args a{};
    for (int i = 0; i < 25; ++i) a.in[i] = (const float*)d_in[i];
    a.out = (float*)d_out; a.ws = (unsigned char*)d_ws;
    for (int i = 0; i < 8; ++i) a.ifq.f[i] = powf(500000.0f, -(float)(2 * i) / 16.0f);
    for (int li = 0; li < N_LAUNCHES; ++li) {
        a.ph_lo = (N_LAUNCHES == 1) ? 0 : li; a.ph_hi = (N_LAUNCHES == 1) ? NPH : li + 1;
        hipLaunchKernelGGL(hymba_fwd, dim3(grid), dim3(NWAVES * 64), LDS_BYTES, stream, a);
    }
#if PROBE_PHASE == 99
    }
#endif
}
```

```cpp
#include <hip/hip_runtime.h>
#include <hip/hip_bf16.h>
#include <cstdio>
#include <cstdint>
#include <cmath>
namespace pg8 {
#define PG8_LAS __attribute__((address_space(3)))
typedef unsigned short bf16_t;
typedef short bf16x8 __attribute__((ext_vector_type(8)));
typedef float f32x4 __attribute__((ext_vector_type(4)));
typedef unsigned u32x4 __attribute__((ext_vector_type(4)));
typedef unsigned u32x2 __attribute__((ext_vector_type(2)));
constexpr int BM = 256, BK = 64, HALF = 128, HTB = HALF * BK * 2  , STAGE_BYTES = 8 * HTB, NXCD = 8, WGM = 8;

__host__ __device__ __forceinline__ int lds_byte(int r, int c) { const int st = (r >> 4) * 2 + (c >> 5), rr = r & 15, cc = c & 31, ob = rr * 64 + cc * 2; return st * 1024 + (ob ^ (((ob >> 9) & 1) << 5)); }
__host__ __device__ __forceinline__ void stage_rc(int b, int& R, int& C) { const int st = b / 1024, sb = b % 1024, swz = sb ^ (((sb >> 9) & 1) << 5); R = (st >> 1) * 16 + swz / 64; C = (st & 1) * 32 + (swz % 64) / 2; }
__host__ __device__ __forceinline__ int perm32(int rho) { const int n = rho >> 4, i = rho & 15; return 8 * (i >> 2) + 4 * n + (i & 3); }

struct Unit { int arow, brow, pm, pn, e, nvalid; const int* lst; const float* vals; };
struct Gemm { const bf16_t* A; const bf16_t* Bt; int K; };

__device__ __forceinline__ unsigned cvt_pk_bf16(float lo, float hi) { unsigned r; asm volatile("v_cvt_pk_bf16_f32 %0, %1, %2" : "=v"(r) : "v"(lo), "v"(hi)); return r; }
#ifndef WT_STORES
#define WT_STORES 0
#endif
__device__ __forceinline__ void st16_wt(void* p, u32x4 v) {
#if WT_STORES == 1
    asm volatile("global_store_dwordx4 %0, %1, off sc1\n\ts_nop 1" :: "v"(p), "v"(v) : "memory");
#elif WT_STORES == 2
    __builtin_nontemporal_store(v, (u32x4*)p);
#else
    *(u32x4*)p = v;
#endif
}
__device__ __forceinline__ float bf_lo(unsigned w) { return __uint_as_float(w << 16); }
__device__ __forceinline__ float bf_hi(unsigned w) { return __uint_as_float(w & 0xffff0000u); }
typedef float f32x2 __attribute__((ext_vector_type(2)));
__device__ __forceinline__ f32x2 gelu_pk(f32x2 v) {
    const f32x2 six = {6.0f, 6.0f};
    const f32x2 a = __builtin_elementwise_min(__builtin_elementwise_abs(v), six);
    f32x2 q = a * 3.177505399e-05f + (-7.569172928e-04f); q = q * a + 8.036978825e-03f; q = q * a + (-5.333741004e-02f); q = q * a + (-4.588343251e-01f); q = q * a + (-1.151177110f); q = q * a + (-0.999996328550283f);
    f32x2 h; h.x = __builtin_amdgcn_exp2f(q.x); h.y = __builtin_amdgcn_exp2f(q.y);
    const f32x2 m = v * h, r = v - m;
    f32x2 o; o.x = v.x < 0.f ? m.x : r.x; o.y = v.y < 0.f ? m.y : r.y; return o;
}

struct StaticOrder {
    int nM, nN, nwg, G, c;
    __device__ void init(int M, int N, int G_, int c_) { nM = M / BM; nN = N / BM; nwg = nM * nN; G = G_; c = c_; }
    __device__ bool next(int i, Unit& u) const {
        const long L = (long)i * G + c; if (L >= nwg) return false;
        int wgid = (int)L; { const int q = nwg / NXCD, r = nwg % NXCD, xcd = wgid % NXCD, off = wgid / NXCD; wgid = (xcd < r ? xcd * (q + 1) : r * (q + 1) + (xcd - r) * q) + off; }
        const int nig = WGM * nN, gid = wgid / nig, fm = gid * WGM, gsz = (nM - fm) < WGM ? (nM - fm) : WGM;
        u.pm = fm + ((wgid % nig) % gsz); u.pn = (wgid % nig) / gsz; u.arow = u.pm * BM; u.brow = u.pn * BM; u.e = 0; u.nvalid = BM; u.lst = nullptr; u.vals = nullptr; return true;
    }
    static constexpr bool ROWREC = false;
};

template <int NM, int NN> struct StaticOrderT {
    int G, c;
    __device__ void init(int G_, int c_) { G = G_; c = c_; }
    __device__ bool next(int i, Unit& u) const {
        constexpr int nwg = NM * NN, q = nwg / NXCD, r = nwg % NXCD, nig = WGM * NN; static_assert(NM % WGM == 0, "whole row groups");
        const long L = (long)i * G + c; if (L >= nwg) return false;
        int wgid = (int)L; { const int xcd = wgid % NXCD, off = wgid / NXCD; wgid = (xcd < r ? xcd * (q + 1) : r * (q + 1) + (xcd - r) * q) + off; }
        const int gid = wgid / nig, fm = gid * WGM, w = wgid % nig;
        u.pm = fm + (w % WGM); u.pn = w / WGM; u.arow = u.pm * BM; u.brow = u.pn * BM; u.e = 0; u.nvalid = BM; u.lst = nullptr; u.vals = nullptr; return true;
    }
    static constexpr bool ROWREC = false;
};

typedef int v8i32 __attribute__((ext_vector_type(8)));
typedef int v4i32 __attribute__((ext_vector_type(4)));
__device__ __forceinline__ v8i32 cat8(bf16x8 lo, bf16x8 hi) { const v4i32 a = __builtin_bit_cast(v4i32, lo), b = __builtin_bit_cast(v4i32, hi); return __builtin_shufflevector(a, b, 0, 1, 2, 3, 4, 5, 6, 7); }
__device__ __forceinline__ void mfma8(f32x4& c, const v8i32& a, const v8i32& b, const int sc) {
    asm volatile("v_mfma_scale_f32_16x16x128_f8f6f4 %0, %1, %2, %0, %3, %3 op_sel_hi:[0,0,0]" : "+v"(c) : "v"(a), "v"(b), "v"(sc)); }
template <class Epi, class Sched, bool GATHER, bool FP8 = false>
__device__ __forceinline__ void gemm_phase(PG8_LAS unsigned char* lds, const Gemm g, const Sched& S, const Epi& E, const int wid  ) {
    int lane; asm volatile("v_mbcnt_lo_u32_b32 %0, -1, 0\n\tv_mbcnt_hi_u32_b32 %0, -1, %0" : "=v"(lane));
    const int tid = wid * 64 + lane, wr = wid >> 2, wc = wid & 3, fr = lane & 15, fq = lane >> 4;
    const int K = g.K, nt = K / BK;
    unsigned voffA[2], voffB[2]; int RA[2], CA[2];
#pragma unroll
    for (int i = 0; i < 2; ++i) { int R, C; stage_rc(tid * 16 + i * 8192, R, C); const int Rb = (R & ~31) + perm32(R & 31);
        voffA[i] = (unsigned)(R * K + C) * 2u; voffB[i] = (unsigned)(Rb * K + C) * 2u; RA[i] = R; CA[i] = C * 2; }
    const size_t kstep = (size_t)(BK * 2);
    const size_t hstep = (size_t)HALF * K * 2;
    const unsigned ldsw = (unsigned)wid * 1024u;
    const int aoff = lds_byte(wr * 64 + fr, fq * 8), boff = lds_byte(wc * 32 + fr, fq * 8);
#define PG8_SA(b, h) (((b) * 2 + (h)) * HTB)
#define PG8_SB(b, h) ((4 + (b) * 2 + (h)) * HTB)
#define PG8_STAGE(bufoff, gbase, voff) do { _Pragma("unroll") for (int _i = 0; _i < 2; ++_i) \
        __builtin_amdgcn_global_load_lds((const unsigned*)((const char*)(gbase) + (voff)[_i]), (PG8_LAS unsigned*)(lds + (bufoff) + ldsw + _i * 8192), 16, 0, 0); } while (0)
#define PG8_STAGE_A(bufoff, kofs, h, nx) do { if constexpr (GATHER) { unsigned _o[2]; _o[0] = (nx) ? gN[h][0] : gC[h][0]; _o[1] = (nx) ? gN[h][1] : gC[h][1]; PG8_STAGE(bufoff, (const char*)g.A + (kofs), _o); } \
        else { PG8_STAGE(bufoff, ((nx) ? nA : cA) + (size_t)(h) * hstep + (kofs), voffA); } } while (0)
#define PG8_LDA(dst, b, h) do { if constexpr (FP8) { _Pragma("unroll") for (int m = 0; m < 4; ++m) dst##8[m] = cat8(*(const PG8_LAS bf16x8*)(lds + PG8_SA(b, h) + aoff + m * 2048), *(const PG8_LAS bf16x8*)(lds + PG8_SA(b, h) + aoff + m * 2048 + 1024)); } \
        else { _Pragma("unroll") for (int m = 0; m < 4; ++m) _Pragma("unroll") for (int k = 0; k < 2; ++k) dst[m][k] = *(const PG8_LAS bf16x8*)(lds + PG8_SA(b, h) + aoff + m * 2048 + k * 1024); } } while (0)
#define PG8_LDB(dst, b, h) do { if constexpr (FP8) { _Pragma("unroll") for (int n = 0; n < 2; ++n) dst##8[n] = cat8(*(const PG8_LAS bf16x8*)(lds + PG8_SB(b, h) + boff + n * 2048), *(const PG8_LAS bf16x8*)(lds + PG8_SB(b, h) + boff + n * 2048 + 1024)); } \
        else { _Pragma("unroll") for (int n = 0; n < 2; ++n) _Pragma("unroll") for (int k = 0; k < 2; ++k) dst[n][k] = *(const PG8_LAS bf16x8*)(lds + PG8_SB(b, h) + boff + n * 2048 + k * 1024); } } while (0)
#define PG8_MMA(ai, bj, At, Bt) do { __builtin_amdgcn_s_setprio(1); if constexpr (FP8) { _Pragma("unroll") for (int m = 0; m < 4; ++m) _Pragma("unroll") for (int n = 0; n < 2; ++n) \
        mfma8(acc[ai][bj][m][n], Bt##8[n], At##8[m], sc1); } else { \
        _Pragma("unroll") for (int m = 0; m < 4; ++m) _Pragma("unroll") for (int n = 0; n < 2; ++n) _Pragma("unroll") for (int k = 0; k < 2; ++k) \
        acc[ai][bj][m][n] = __builtin_amdgcn_mfma_f32_16x16x32_bf16(Bt[n][k], At[m][k], acc[ai][bj][m][n], 0, 0, 0); } __builtin_amdgcn_s_setprio(0); } while (0)
#define PG8_WAIT_V(n) asm volatile("s_waitcnt vmcnt(" #n ")" ::: "memory")
#define PG8_WAIT_L(n) asm volatile("s_waitcnt lgkmcnt(" #n ")" ::: "memory")
#define PG8_BAR __builtin_amdgcn_s_barrier()
#define PG8_SCHED __builtin_amdgcn_sched_barrier(0)
#define PG8_GOFF(G_, U) do { _Pragma("unroll") for (int _h = 0; _h < 2; ++_h) _Pragma("unroll") for (int _i = 0; _i < 2; ++_i) { int _ix = _h * HALF + RA[_i]; _ix = _ix < (U).nvalid ? _ix : (U).nvalid - 1; \
        const int _p = (U).lst[_ix]; G_[_h][_i] = (unsigned)(_p >> 1) * (unsigned)(K * 2) + (unsigned)CA[_i]; } } while (0)
    Unit cur, nxt; int ui = 0;
    if (!S.next(0, cur)) return;
    f32x4 acc[2][2][4][2];
#pragma unroll
    for (int a = 0; a < 2; ++a)
#pragma unroll
        for (int b = 0; b < 2; ++b)
#pragma unroll
            for (int m = 0; m < 4; ++m)
#pragma unroll
                for (int n = 0; n < 2; ++n) acc[a][b][m][n] = (f32x4){0.f, 0.f, 0.f, 0.f};
    bf16x8 At[4][2], B0[2][2], B1[2][2]; v8i32 At8[4], B08[2], B18[2];
    int sc1 = 0x7f7f7f7f; asm volatile("" : "+v"(sc1));
    unsigned gC[2][2] = {{0u, 0u}, {0u, 0u}}, gN[2][2] = {{0u, 0u}, {0u, 0u}};
    if constexpr (GATHER) { PG8_GOFF(gC, cur); }
    const char* cA = (const char*)g.A + (size_t)cur.arow * K * 2; const char* cB = (const char*)g.Bt + (size_t)cur.brow * K * 2;
    const char* nA = cA; const char* nB = cB;
    PG8_STAGE(PG8_SB(0, 0), cB, voffB); PG8_STAGE(PG8_SB(0, 1), cB + hstep, voffB); PG8_STAGE_A(PG8_SA(0, 0), 0, 0, false); PG8_STAGE_A(PG8_SA(0, 1), 0, 1, false);
    if (wr == 1) PG8_BAR;
    PG8_WAIT_V(2); PG8_BAR;
    PG8_STAGE(PG8_SB(1, 0), cB + kstep, voffB); PG8_STAGE_A(PG8_SA(1, 0), kstep, 0, false); PG8_STAGE(PG8_SB(1, 1), cB + hstep + kstep, voffB);
    PG8_WAIT_V(6); PG8_BAR;
    for (;;) {
        const bool has_next = S.next(ui + 1, nxt);
        int rrp = 0; float rrv = 0.f;
        if constexpr (Sched::ROWREC) { if (wr == 0) { const int ix = tid < cur.nvalid ? tid : cur.nvalid - 1; rrp = cur.lst[ix]; rrv = cur.vals[2 * ix + Sched::VALSEL]; } }
        nA = has_next ? (const char*)g.A + (size_t)nxt.arow * K * 2 : cA; nB = has_next ? (const char*)g.Bt + (size_t)nxt.brow * K * 2 : cB;
        if constexpr (GATHER) { if (has_next) { PG8_GOFF(gN, nxt); } else { gN[0][0] = gC[0][0]; gN[0][1] = gC[0][1]; gN[1][0] = gC[1][0]; gN[1][1] = gC[1][1]; } }
#pragma clang loop unroll(disable)
        for (int t = 0; t < nt; t += 2) {
            const bool last = (t == nt - 2);
            const size_t k1 = (size_t)(t + 1) * kstep;
            const size_t k2 = last ? (size_t)0 : (size_t)(t + 2) * kstep;
            const char* b2 = last ? nB : cB + (size_t)(t + 2) * kstep;
            const size_t k3 = k2 + kstep; const char* b3 = b2 + kstep;
            PG8_LDB(B0, 0, 0); PG8_LDB(B1, 0, 1); PG8_SCHED; PG8_LDA(At, 0, 0); PG8_STAGE_A(PG8_SA(1, 1), k1, 1, false);
            PG8_WAIT_V(8); PG8_WAIT_L(0); PG8_BAR; PG8_MMA(0, 0, At, B0); PG8_MMA(0, 1, At, B1); PG8_BAR; PG8_SCHED;
            PG8_LDA(At, 0, 1); PG8_STAGE(PG8_SB(0, 0), b2, voffB); PG8_STAGE(PG8_SB(0, 1), b2 + hstep, voffB); PG8_STAGE_A(PG8_SA(0, 0), k2, 0, last);
            PG8_WAIT_V(8); PG8_WAIT_L(0); PG8_BAR; PG8_MMA(1, 0, At, B0); PG8_MMA(1, 1, At, B1); PG8_BAR; PG8_SCHED;
            PG8_LDB(B0, 1, 0); PG8_LDB(B1, 1, 1); PG8_SCHED; PG8_LDA(At, 1, 0); PG8_STAGE_A(PG8_SA(0, 1), k2, 1, last);
            PG8_WAIT_V(8); PG8_WAIT_L(0); PG8_BAR; PG8_MMA(0, 0, At, B0); PG8_MMA(0, 1, At, B1); PG8_BAR; PG8_SCHED;
            PG8_LDA(At, 1, 1); PG8_STAGE(PG8_SB(1, 0), b3, voffB); PG8_STAGE(PG8_SB(1, 1), b3 + hstep, voffB); PG8_STAGE_A(PG8_SA(1, 0), k3, 0, last);
            PG8_WAIT_V(8); PG8_WAIT_L(0); PG8_BAR; PG8_MMA(1, 0, At, B0); PG8_MMA(1, 1, At, B1); PG8_BAR; PG8_SCHED;
        }
        if constexpr (Sched::ROWREC) { if (wr == 0) { *(PG8_LAS u32x2*)(S.rowtab + tid * 8) = (u32x2){(unsigned)rrp, __float_as_uint(rrv)}; PG8_WAIT_L(0); } }
        if (wr == 0) PG8_BAR;
        if constexpr (FP8) asm volatile("s_nop 15\n\ts_nop 15" ::: "memory");
        E(acc, cur, wr, wc, fr, fq);
        if (!has_next) break;
#pragma unroll
        for (int a = 0; a < 2; ++a)
#pragma unroll
            for (int b = 0; b < 2; ++b)
#pragma unroll
                for (int m = 0; m < 4; ++m)
#pragma unroll
                    for (int n = 0; n < 2; ++n) acc[a][b][m][n] = (f32x4){0.f, 0.f, 0.f, 0.f};
        cur = nxt; cA = nA; cB = nB; ++ui;
        if constexpr (GATHER) { gC[0][0] = gN[0][0]; gC[0][1] = gN[0][1]; gC[1][0] = gN[1][0]; gC[1][1] = gN[1][1]; }
        if (wr == 1) PG8_BAR;
    }
    PG8_WAIT_V(0);
    PG8_BAR;
#undef PG8_SA
#undef PG8_SB
#undef PG8_STAGE
#undef PG8_STAGE_A
#undef PG8_LDA
#undef PG8_LDB
#undef PG8_MMA
#undef PG8_WAIT_V
#undef PG8_WAIT_L
#undef PG8_BAR
#undef PG8_SCHED
#undef PG8_GOFF
}
}
namespace pg8 {
template <int MASK> __device__ __forceinline__ float sxor(float v) { return __builtin_bit_cast(float, __builtin_amdgcn_ds_swizzle(__builtin_bit_cast(int, v), (MASK << 10) | 0x1f)); }
__device__ __forceinline__ float sum32(float v) { auto r = __builtin_amdgcn_permlane32_swap(__float_as_uint(v), __float_as_uint(v), false, false); return __uint_as_float(r[0]) + __uint_as_float(r[1]); }
constexpr float RMS_EPS = 1e-6f;
constexpr float H8_SCALE = 16.0f, W1_SCALE = 256.0f, ACT_SCALE = 8.0f, W2_SCALE = 128.0f, Y8_SCALE = 64.0f;
__device__ __forceinline__ float clamp8(float v) { return __builtin_fminf(__builtin_fmaxf(v, -448.0f), 448.0f); }
__device__ __forceinline__ unsigned pk4_fp8(float a, float b, float c, float d) { int w = 0; w = __builtin_amdgcn_cvt_pk_fp8_f32(clamp8(a), clamp8(b), w, false); w = __builtin_amdgcn_cvt_pk_fp8_f32(clamp8(c), clamp8(d), w, true); return (unsigned)w; }
constexpr float QSCALE_C2 = 0.125f * 1.4426950408889634f;

struct EpiInProj {
    bf16_t *q, *k, *v, *su, *sv; const float* rstd1; const float* rope; const float* qg; const float* kg; float* svst; int mode;
    __device__ __forceinline__ void operator()(const f32x4 (&acc)[2][2][4][2], const Unit& u, int wr, int wc, int fr, int fq) const {
        if (mode == 2) return;
        const int cls = u.pn >> 1, G = (u.pn & 1) * 4 + wc, colbase = G * 64 + 8 * fq;
        bf16_t* dst = cls == 0 ? q : cls == 1 ? k : cls == 2 ? v : cls == 3 ? su : sv;
        float gain[16];
        if (cls < 2) { const float* gp = (cls == 0 ? qg : kg) + 8 * fq;
#pragma unroll
            for (int i = 0; i < 8; ++i) { gain[i] = gp[i]; gain[8 + i] = gp[32 + i]; } }
        float rsv[2][4];
#pragma unroll
        for (int ai = 0; ai < 2; ++ai)
#pragma unroll
            for (int m = 0; m < 4; ++m) rsv[ai][m] = rstd1[u.pm * BM + ai * HALF + wr * 64 + m * 16 + fr];
        const bool roped = cls < 2 && fq < 2;
        f32x4 rpc[4] = {}, rpn[4] = {};
        if (roped) { const float* rp_ = rope + (size_t)(u.pm * BM + wr * 64 + fr) * 16;
#pragma unroll
            for (int i = 0; i < 4; ++i) rpc[i] = *(const f32x4*)(rp_ + 4 * i); }
#pragma unroll
        for (int ai = 0; ai < 2; ++ai)
#pragma unroll
            for (int m = 0; m < 4; ++m) {
                const int row = u.pm * BM + ai * HALF + wr * 64 + m * 16 + fr;
                const float rs = rsv[ai][m];
                if (roped && !(ai == 1 && m == 3)) { const int an = (m == 3) ? ai + 1 : ai, mn = (m == 3) ? 0 : m + 1; const float* rp_ = rope + (size_t)(u.pm * BM + an * HALF + wr * 64 + mn * 16 + fr) * 16;
#pragma unroll
                    for (int i = 0; i < 4; ++i) rpn[i] = *(const f32x4*)(rp_ + 4 * i); }
                float x[16];
#pragma unroll
                for (int bj = 0; bj < 2; ++bj)
#pragma unroll
                    for (int n = 0; n < 2; ++n)
#pragma unroll
                        for (int j = 0; j < 4; ++j) x[8 * bj + 4 * n + j] = acc[ai][bj][m][n][j] * rs;
                if (cls < 2) {
                    float ss = 0.f;
#pragma unroll
                    for (int i = 0; i < 16; ++i) ss += x[i] * x[i];
                    ss += sxor<16>(ss); ss = sum32(ss);
                    const float rn = __builtin_amdgcn_rsqf(ss * (1.0f / 64.0f) + RMS_EPS);
#pragma unroll
                    for (int i = 0; i < 16; ++i) x[i] = x[i] * rn * gain[i];
                    float oth[8];
#pragma unroll
                    for (int i = 0; i < 8; ++i) oth[i] = sxor<16>(x[i]);
                    if (fq < 2) {
                        const f32x4 c0 = rpc[0], c1 = rpc[1], s0 = rpc[2], s1 = rpc[3];
#pragma unroll
                        for (int i = 0; i < 8; ++i) { const float c = i < 4 ? c0[i & 3] : c1[i & 3], s = i < 4 ? s0[i & 3] : s1[i & 3];
                            x[i] = fq == 0 ? x[i] * c - oth[i] * s : oth[i] * s + x[i] * c; }
                    }
                    if (cls == 0) {
#pragma unroll
                        for (int i = 0; i < 16; ++i) x[i] *= QSCALE_C2; }
                } else if (cls == 4) {
#pragma unroll
                    for (int i = 0; i < 16; i += 2) { const f32x2 gv = gelu_pk((f32x2){x[i], x[i + 1]}); x[i] = gv.x; x[i + 1] = gv.y; }
                    {
                        float s1 = 0.f, s2 = 0.f;
#pragma unroll
                        for (int i = 0; i < 16; ++i) { s1 += x[i]; s2 += x[i] * x[i]; }
                        s1 += sxor<16>(s1); s1 = sum32(s1); s2 += sxor<16>(s2); s2 = sum32(s2);
                        if (fq == 0) *(f32x2*)(svst + (size_t)row * 16 + G * 2) = (f32x2){s1, s2};
                    }
                }
                u32x4 w0, w1;
                w0.x = cvt_pk_bf16(x[0], x[1]); w0.y = cvt_pk_bf16(x[2], x[3]); w0.z = cvt_pk_bf16(x[4], x[5]); w0.w = cvt_pk_bf16(x[6], x[7]);
                w1.x = cvt_pk_bf16(x[8], x[9]); w1.y = cvt_pk_bf16(x[10], x[11]); w1.z = cvt_pk_bf16(x[12], x[13]); w1.w = cvt_pk_bf16(x[14], x[15]);
                bf16_t* rp = dst + (size_t)row * 512 + colbase;
                st16_wt(rp, w0); st16_wt(rp + 32, w1);
#pragma unroll
                for (int i = 0; i < 4; ++i) rpc[i] = rpn[i];
            }
    }
};

struct EpiOutProj {
    const bf16_t* xb; bf16_t* hb; float* hst;
    __device__ __forceinline__ void operator()(const f32x4 (&acc)[2][2][4][2], const Unit& u, int wr, int wc, int fr, int fq) const {
        u32x4 xr[2][4][2];
#pragma unroll
        for (int ai = 0; ai < 2; ++ai)
#pragma unroll
            for (int m = 0; m < 4; ++m)
#pragma unroll
                for (int bj = 0; bj < 2; ++bj)
                    xr[ai][m][bj] = *(const u32x4*)(xb + (size_t)(u.pm * BM + ai * HALF + wr * 64 + m * 16 + fr) * 1024 + u.pn * BM + bj * HALF + wc * 32 + 8 * fq);
#pragma unroll
        for (int ai = 0; ai < 2; ++ai)
#pragma unroll
            for (int m = 0; m < 4; ++m) {
                const int row = u.pm * BM + ai * HALF + wr * 64 + m * 16 + fr;
                float ss = 0.f;
#pragma unroll
                for (int bj = 0; bj < 2; ++bj) {
                    const size_t off = (size_t)row * 1024 + u.pn * BM + bj * HALF + wc * 32 + 8 * fq;
                    const u32x4 xw = xr[ai][m][bj];
                    const f32x4 h0 = (f32x4){bf_lo(xw.x), bf_hi(xw.x), bf_lo(xw.y), bf_hi(xw.y)} + acc[ai][bj][m][0], h1 = (f32x4){bf_lo(xw.z), bf_hi(xw.z), bf_lo(xw.w), bf_hi(xw.w)} + acc[ai][bj][m][1];
                    u32x4 w; w.x = cvt_pk_bf16(h0[0], h0[1]); w.y = cvt_pk_bf16(h0[2], h0[3]); w.z = cvt_pk_bf16(h1[0], h1[1]); w.w = cvt_pk_bf16(h1[2], h1[3]);
                    st16_wt(hb + off, w);
                    ss += (h0[0] * h0[0] + h0[1] * h0[1]) + (h0[2] * h0[2] + h0[3] * h0[3]) + (h1[0] * h1[0] + h1[1] * h1[1]) + (h1[2] * h1[2] + h1[3] * h1[3]);
                }
                ss += sxor<16>(ss); ss = sum32(ss);
                if (fq == 0) hst[(size_t)row * 16 + u.pn * 4 + wc] = ss;
            }
    }
};

struct EpiMoeUp {
    unsigned char* act8; const PG8_LAS unsigned char* rowtab; unsigned char* dump;
    __device__ __forceinline__ void operator()(const f32x4 (&acc)[2][2][4][2], const Unit& u, int wr, int wc, int fr, int fq) const {
#pragma unroll
        for (int ai = 0; ai < 2; ++ai)
#pragma unroll
            for (int m = 0; m < 4; ++m) {
                const int rl = ai * HALF + wr * 64 + m * 16 + fr;
                const bool valid = rl < u.nvalid;
                const float rs = __uint_as_float((*(const PG8_LAS u32x2*)(rowtab + rl * 8)).y) * (1.0f / (H8_SCALE * W1_SCALE));
                float a[8]; const float kx = rs * (-1.4426950408889634f), cx = rs * rs * ACT_SCALE;
#pragma unroll
                for (int n = 0; n < 2; ++n)
#pragma unroll
                    for (int j = 0; j < 4; j += 2) { const f32x2 g2 = {acc[ai][0][m][n][j], acc[ai][0][m][n][j + 1]}, u2 = {acc[ai][1][m][n][j], acc[ai][1][m][n][j + 1]};
                        const f32x2 ea = g2 * kx; f32x2 d2; d2.x = __builtin_amdgcn_exp2f(ea.x); d2.y = __builtin_amdgcn_exp2f(ea.y); d2 = d2 + 1.0f;
                        f32x2 r2; r2.x = __builtin_amdgcn_rcpf(d2.x); r2.y = __builtin_amdgcn_rcpf(d2.y);
                        const f32x2 o2 = ((g2 * u2) * r2) * cx; a[4 * n + j] = o2.x; a[4 * n + j + 1] = o2.y; }
                unsigned char* dp = valid ? act8 + (size_t)(u.arow + rl) * 512 + u.pn * 128 + wc * 32 + 8 * fq : dump + (fr * 4 + fq) * 16;
                *(u32x2*)dp = (u32x2){pk4_fp8(a[0], a[1], a[2], a[3]), pk4_fp8(a[4], a[5], a[6], a[7])};
            }
    }
};

struct EpiMoeDown {
    unsigned char* y8; const PG8_LAS unsigned char* rowtab; int mode;
    __device__ __forceinline__ void operator()(const f32x4 (&acc)[2][2][4][2], const Unit& u, int wr, int wc, int fr, int fq) const {
        if (mode == 2) return;
#pragma unroll
        for (int ai = 0; ai < 2; ++ai)
#pragma unroll
            for (int m = 0; m < 4; ++m) {
                const int rl = ai * HALF + wr * 64 + m * 16 + fr;
                const bool valid = (rl < u.nvalid) && (mode == 0);
                const u32x2 rec = *(const PG8_LAS u32x2*)(rowtab + rl * 8); const int p = (int)rec.x;
                const float gw = __uint_as_float(rec.y) * (Y8_SCALE / (ACT_SCALE * W2_SCALE));
                const f32x4 a0 = acc[ai][0][m][0] * gw, a1 = acc[ai][0][m][1] * gw, b0 = acc[ai][1][m][0] * gw, b1 = acc[ai][1][m][1] * gw;
                const u32x4 w = (u32x4){pk4_fp8(a0[0], a0[1], a0[2], a0[3]), pk4_fp8(a1[0], a1[1], a1[2], a1[3]), pk4_fp8(b0[0], b0[1], b0[2], b0[3]), pk4_fp8(b1[0], b1[1], b1[2], b1[3])};
                if (valid) __builtin_nontemporal_store(w, (u32x4*)(y8 + (size_t)p * 1024 + u.pn * BM + wc * 64 + 16 * fq)); else asm volatile("" :: "v"(w));
            }
    }
};
}
#include <hip/hip_bf16.h>
#include <cmath>
namespace attn_body {
using bf16=__hip_bfloat16;
using bf16x8=__attribute__((ext_vector_type(8)))short;
using s16x4=__attribute__((ext_vector_type(4)))short;
using f32x16=__attribute__((ext_vector_type(16)))float;
using u32x4=__attribute__((ext_vector_type(4)))unsigned;
constexpr int SEQ=2048,D=64,QP=512,KP=512,VP=512,OP=1024;
constexpr int NW=8,QBLK=32,QB=QBLK*NW,KVBLK=64,NQB=SEQ/QB;
constexpr int ATTN_UNIT_ROWS=QB;
__device__ __forceinline__ int crow(int r,int hi){return (r&3)+8*(r>>2)+4*hi;}
#define SBAR() __builtin_amdgcn_sched_barrier(0)
__device__ __forceinline__ void cmask(f32x16&p0,f32x16&p1,int jb,int qrel,int hi){
  const float NEG=-INFINITY; int kb=64*jb+4*hi;
  #pragma unroll
  for(int r=0;r<16;++r){int kv=kb+(r&3)+8*(r>>2); if(kv>qrel)p0[r]=NEG; if(kv+32>qrel)p1[r]=NEG;}
}

struct MainT{static constexpr bool value=false;}; struct BandT{static constexpr bool value=true;};
__device__ __forceinline__ void bandfill(f32x16&c,const int d,const int r32,const int hi){
  if(d>=32){
    #pragma unroll
    for(int r=0;r<16;++r)c[r]=0.f;
  }else if(d<=-32){
    #pragma unroll
    for(int r=0;r<16;++r)c[r]=-INFINITY;
  }else{
    #pragma unroll
    for(int r=0;r<16;++r)c[r]=((r&3)+8*(r>>2)+4*hi>r32)?-INFINITY:0.f;
  }
}
constexpr int NSLOT=3, SLOTB=8192;
constexpr int LDS_K=0, LDS_V=NSLOT*SLOTB, LDS_WS=2*NSLOT*SLOTB, LDS_OST=LDS_WS+NW*64*4, LDS_BYTES=LDS_OST+NW*4096;
constexpr float C2=0.125f*1.4426950408889634f;
__device__ __forceinline__ void glds16(const void*gsrc,unsigned lds_dst){unsigned keep;
  asm volatile("s_mov_b32 %0, m0\n\ts_mov_b32 m0, %2\n\ts_nop 0\n\tglobal_load_lds_dwordx4 %1, off\n\ts_mov_b32 m0, %0":"=&s"(keep):"v"(gsrc),"s"(lds_dst):"memory");}
__device__ __forceinline__ float max3f(float a,float b,float c){float r;asm("v_max3_f32 %0, %1, %2, %3":"=v"(r):"v"(a),"v"(b),"v"(c));return r;}
__device__ __forceinline__ float max2f(float a,float b){float r;asm("v_max_f32_e32 %0, %1, %2":"=v"(r):"v"(a),"v"(b));return r;}
__device__ __forceinline__ float fadd_s(float a,float b){float r;asm("v_add_f32_e32 %0, %1, %2":"=v"(r):"v"(a),"v"(b));return r;}
__device__ __forceinline__ float fsub_s(float a,float b){float r;asm("v_sub_f32_e32 %0, %1, %2":"=v"(r):"v"(a),"v"(b));return r;}
typedef float f32x2_t __attribute__((ext_vector_type(2))); typedef __bf16 bf16x2_t __attribute__((ext_vector_type(2)));
__device__ __forceinline__ unsigned cvtpk_s(float lo,float hi){f32x2_t v={lo,hi};bf16x2_t b=__builtin_convertvector(v,bf16x2_t);return __builtin_bit_cast(unsigned,b);}
#define WAIT_BAR(N) asm volatile("s_waitcnt vmcnt(" #N ") lgkmcnt(0)\n\ts_barrier":::"memory")

__device__ __forceinline__ void qkt(f32x16&p0,f32x16&p1,const char*Kslot,const bf16x8*qr,const f32x16&negm,int r32,int hi){
  const char*kb=Kslot+hi*1024+r32*16;
  #pragma unroll
  for(int d0=0;d0<4;++d0){
    const bf16x8 b0=*reinterpret_cast<const bf16x8*>(kb+d0*2048);
    const bf16x8 b1=*reinterpret_cast<const bf16x8*>(kb+d0*2048+512);
    if(d0==0){p0=__builtin_amdgcn_mfma_f32_32x32x16_bf16(b0,qr[0],negm,0,0,0);p1=__builtin_amdgcn_mfma_f32_32x32x16_bf16(b1,qr[0],negm,0,0,0);}
    else{p0=__builtin_amdgcn_mfma_f32_32x32x16_bf16(b0,qr[d0],p0,0,0,0);p1=__builtin_amdgcn_mfma_f32_32x32x16_bf16(b1,qr[d0],p1,0,0,0);}}
}
typedef __attribute__((address_space(3))) const char* lds_cptr;
typedef short v4i16_t __attribute__((ext_vector_type(4)));
__device__ __forceinline__ void kload8(bf16x8*kf,lds_cptr kp){
  kf[0]=*(const __attribute__((address_space(3))) bf16x8*)(kp);      kf[1]=*(const __attribute__((address_space(3))) bf16x8*)(kp+512);
  kf[2]=*(const __attribute__((address_space(3))) bf16x8*)(kp+2048); kf[3]=*(const __attribute__((address_space(3))) bf16x8*)(kp+2560);
  kf[4]=*(const __attribute__((address_space(3))) bf16x8*)(kp+4096); kf[5]=*(const __attribute__((address_space(3))) bf16x8*)(kp+4608);
  kf[6]=*(const __attribute__((address_space(3))) bf16x8*)(kp+6144); kf[7]=*(const __attribute__((address_space(3))) bf16x8*)(kp+6656);
}
__device__ __forceinline__ void kload2(bf16x8*kf,lds_cptr kp,int j){ kf[2*j]=*(const __attribute__((address_space(3))) bf16x8*)(kp+j*2048); kf[2*j+1]=*(const __attribute__((address_space(3))) bf16x8*)(kp+j*2048+512); }
__device__ __forceinline__ s16x4 vtr(lds_cptr p){ return __builtin_bit_cast(s16x4,__builtin_amdgcn_ds_read_tr16_b64_v4i16((__attribute__((address_space(3))) v4i16_t*)p)); }
__device__ __forceinline__ float rowmax(const f32x16&p0,const f32x16&p1){
  float a=max3f(p0[0],p0[1],p1[0]),b=max3f(p0[2],p0[3],p1[1]);a=max3f(a,p1[2],p1[3]);
  #pragma unroll
  for(int r=4;r<16;r+=4){a=max3f(a,p0[r],p0[r+1]);b=max3f(b,p0[r+2],p0[r+3]);a=max3f(a,p1[r],p1[r+1]);b=max3f(b,p1[r+2],p1[r+3]);}
  const float m=max2f(a,b);
  auto rr=__builtin_amdgcn_permlane32_swap(__float_as_uint(m),__float_as_uint(m),false,false);
  return max2f(__uint_as_float(rr[0]),__uint_as_float(rr[1]));
}
__device__ __forceinline__ void pv(f32x16*o,int vb,bf16x8 pa0,bf16x8 pa1,bf16x8 pa2,bf16x8 pa3){
  #pragma unroll
  for(int d0=0;d0<2;++d0){s16x4 lo[4],hi[4];
    #pragma unroll
    for(int ks=0;ks<4;++ks){
      asm volatile("ds_read_b64_tr_b16 %0,%1 offset:%c2":"=&v"(lo[ks]):"v"(vb),"i"(d0*4096+ks*1024):"memory");
      asm volatile("ds_read_b64_tr_b16 %0,%1 offset:%c2":"=&v"(hi[ks]):"v"(vb),"i"(d0*4096+ks*1024+512):"memory");}
    asm volatile("s_waitcnt lgkmcnt(0)":::"memory");SBAR();
    #define PK(k) (bf16x8){lo[k][0],lo[k][1],lo[k][2],lo[k][3],hi[k][0],hi[k][1],hi[k][2],hi[k][3]}
    o[d0]=__builtin_amdgcn_mfma_f32_32x32x16_bf16(pa0,PK(0),o[d0],0,0,0);
    o[d0]=__builtin_amdgcn_mfma_f32_32x32x16_bf16(pa1,PK(1),o[d0],0,0,0);
    o[d0]=__builtin_amdgcn_mfma_f32_32x32x16_bf16(pa2,PK(2),o[d0],0,0,0);
    o[d0]=__builtin_amdgcn_mfma_f32_32x32x16_bf16(pa3,PK(3),o[d0],0,0,0);
    #undef PK
  }
}

#ifndef ATTN_STORE16
#define ATTN_STORE16(p,v) (*(u32x4*)(p)=(v))
#endif
__device__ __forceinline__ int olane(){ int l; asm volatile("v_mbcnt_lo_u32_b32 %0, -1, 0\n\tv_mbcnt_hi_u32_b32 %0, -1, %0":"=v"(l)); return l; }
template<int THRL> __device__ __forceinline__ void attn_unit(const int wid,long rowbase,int qb,const bf16*Qc,const bf16*__restrict__ Kc,const bf16*__restrict__ Vc,bf16*Oc,char*shm){
  const int lane=olane(),r32=lane&31,hi=lane>>5;
  const int q0=qb*QB;
  const bf16*Qw=Qc+(rowbase+q0+wid*QBLK)*QP;
  const bf16*Kh=Kc+rowbase*KP,*Vh=Vc+rowbase*VP;
  const unsigned lds0=(unsigned)(uintptr_t)shm;
  float*wsf=(float*)(shm+LDS_WS)+wid*64;
  const bf16*ksrc=Kh+(long)lane*KP+wid*8;
  const bf16*vsrc=Vh+(long)(16*(wid&3)+(lane>>2))*VP+(wid>>2)*32+(lane&3)*8;
  const unsigned kdst=lds0+LDS_K+wid*1024, vdst=lds0+LDS_V+wid*1024;
  #define DMA_K(t,slot) glds16(ksrc+(long)(t)*KVBLK*KP,(unsigned)__builtin_amdgcn_readfirstlane(kdst+(slot)))
  #define DMA_V(t,slot) glds16(vsrc+(long)(t)*KVBLK*VP,(unsigned)__builtin_amdgcn_readfirstlane(vdst+(slot)))
  const int vb0=(int)(lds0+LDS_V)+((lane>>4)&1)*32+(lane&3)*8+(4*hi+((lane&15)>>2))*64;
  const char*Kbase=shm+LDS_K; bf16x8 kf[8];
  const lds_cptr shm3=(lds_cptr)shm; const lds_cptr kp0=shm3+LDS_K+hi*1024+r32*16; const lds_cptr vp0=shm3+LDS_V+((lane>>4)&1)*32+(lane&3)*8+(4*hi+((lane&15)>>2))*64;
  const int NT=(q0+QB)/KVBLK;
  DMA_K(0,0);DMA_V(0,0);DMA_K(1,SLOTB);
  bf16x8 qr[4];
  #pragma unroll
  for(int d0=0;d0<4;++d0)qr[d0]=*reinterpret_cast<const bf16x8*>(&Qw[(long)r32*QP+d0*16+hi*8]);
  float l_reg=0.f;f32x16 o[2];o[0]=f32x16{};o[1]=f32x16{};const f32x16 negm=f32x16{};
  const int qrel=wid*QBLK+r32;
  #define CMASK(P0,P1,t) do{int jb_=(t)-(NT-4); if(jb_>=0)cmask(P0,P1,jb_,qrel,hi);}while(0)
  #define START(P0,P1) do{ _Pragma("unroll") for(int r=0;r<16;++r)P0[r]=__builtin_amdgcn_exp2f(P0[r]); }while(0)
  #define RESC() do{}while(0)
  f32x16 pA0,pA1,pB0,pB1;
  int sl_prev=0,sl_cur=0,sl_next=SLOTB;
  #define ROT() do{sl_prev=sl_cur;sl_cur=sl_next;sl_next=(sl_next==(NSLOT-1)*SLOTB)?0:sl_next+SLOTB;}while(0)
  DMA_K(2,2*SLOTB);
  WAIT_BAR(3);
  qkt(pA0,pA1,Kbase,qr,negm,r32,hi);asm volatile("s_nop 15\n\ts_nop 7":"+v"(pA0),"+v"(pA1));CMASK(pA0,pA1,0);
  START(pA0,pA1);
  _Pragma("unroll") for(int r=0;r<16;++r)pA1[r]=__builtin_amdgcn_exp2f(pA1[r]);
  WAIT_BAR(0);
  DMA_K(3,0);DMA_V(1,SLOTB);
  ROT();
  kload8(kf,kp0+sl_cur);
  WAIT_BAR(2);
  s16x4 vlo[8],vhi[8]; u32x4 pw0,pw1,pw2,pw3;
  #define PKW(P,B) cvtpk_s(P[B],P[B+1])
  #define PAF(k) __builtin_bit_cast(bf16x8,pw##k)
  #define VFR(i) (bf16x8){vlo[i][0],vlo[i][1],vlo[i][2],vlo[i][3],vhi[i][0],vhi[i][1],vhi[i][2],vhi[i][3]}
  #define PIN(x) asm volatile("":"+v"(x))
  #define MX3(a,b,c) __builtin_fmaxf(__builtin_fmaxf((a),(b)),(c))
  #define GAPA(MF,A0,A1,A2,A3,W0,W1,PW) do{ MF; sacc+=A0; sacc+=A1; sacc+=A2; sacc+=A3; PIN(sacc); W0; W1; PIN(PW); SBAR(); }while(0)
  #define EX(v) __builtin_amdgcn_exp2f(v)
  #define GAPB(MF,X,B) do{ MF; X[B]=EX(X[B]); X[B+1]=EX(X[B+1]); X[B+2]=EX(X[B+2]); X[B+3]=EX(X[B+3]); PIN(X); SBAR(); }while(0)
  #define VRD(i) do{ vlo[i]=vtr(vp_+(((i)>>2)*4096+((i)&3)*1024)); vhi[i]=vtr(vp_+(((i)>>2)*4096+((i)&3)*1024+512)); }while(0)
  #define KRD(G,j) do{ if(G){ kload2(kf,kp0+sl_next,j); SBAR(); } }while(0)
  #define STEP(C0,C1,P0,P1,t,GK,GV,GL) do{ SBAR(); \
    const lds_cptr vp_=vp0+sl_prev; \
    VRD(0); SBAR(); float sacc=(P0[0]+P0[1]); \
    GAPA(C0=__builtin_amdgcn_mfma_f32_32x32x16_bf16(kf[0],qr[0],negm,0,0,0), P0[2],P0[3],P0[4],P0[5],     pw0[0]=PKW(P0,0), pw0[1]=PKW(P0,2), pw0); \
    VRD(4); SBAR(); GAPA(C1=__builtin_amdgcn_mfma_f32_32x32x16_bf16(kf[1],qr[0],negm,0,0,0), P0[6],P0[7],P0[8],P0[9],     pw0[2]=PKW(P0,4), pw0[3]=PKW(P0,6), pw0); \
    VRD(1); SBAR(); GAPA(C0=__builtin_amdgcn_mfma_f32_32x32x16_bf16(kf[2],qr[1],C0,0,0,0),   P0[10],P0[11],P0[12],P0[13], pw1[0]=PKW(P0,8), pw1[1]=PKW(P0,10), pw1); \
    VRD(5); SBAR(); GAPA(C1=__builtin_amdgcn_mfma_f32_32x32x16_bf16(kf[3],qr[1],C1,0,0,0),   P0[14],P0[15],P1[0],P1[1],   pw1[2]=PKW(P0,12),pw1[3]=PKW(P0,14), pw1); \
    VRD(2); SBAR(); GAPA(C0=__builtin_amdgcn_mfma_f32_32x32x16_bf16(kf[4],qr[2],C0,0,0,0),   P1[2],P1[3],P1[4],P1[5],     pw2[0]=PKW(P1,0), pw2[1]=PKW(P1,2), pw2); \
    VRD(6); SBAR(); GAPA(C1=__builtin_amdgcn_mfma_f32_32x32x16_bf16(kf[5],qr[2],C1,0,0,0),   P1[6],P1[7],P1[8],P1[9],     pw2[2]=PKW(P1,4), pw2[3]=PKW(P1,6), pw2); \
    VRD(3); SBAR(); GAPA(C0=__builtin_amdgcn_mfma_f32_32x32x16_bf16(kf[6],qr[3],C0,0,0,0),   P1[10],P1[11],P1[12],P1[13], pw3[0]=PKW(P1,8), pw3[1]=PKW(P1,10), pw3); \
    VRD(7); SBAR(); GAPA(C1=__builtin_amdgcn_mfma_f32_32x32x16_bf16(kf[7],qr[3],C1,0,0,0),   P1[14],P1[15],0.f,0.f,       pw3[2]=PKW(P1,12),pw3[3]=PKW(P1,14), pw3); \
    l_reg+=sacc; \
    if(GK){DMA_K((t)+3,sl_cur);} if(GV){DMA_V((t)+1,sl_next);} \
    CMASK(C0,C1,t); \
    SBAR(); \
    GAPB(o[0]=__builtin_amdgcn_mfma_f32_32x32x16_bf16(PAF(0),VFR(0),o[0],0,0,0), C0,0); \
    GAPB(o[1]=__builtin_amdgcn_mfma_f32_32x32x16_bf16(PAF(0),VFR(4),o[1],0,0,0), C0,4); \
    KRD(GL,0); GAPB(o[0]=__builtin_amdgcn_mfma_f32_32x32x16_bf16(PAF(1),VFR(1),o[0],0,0,0), C0,8); \
    KRD(GL,1); GAPB(o[1]=__builtin_amdgcn_mfma_f32_32x32x16_bf16(PAF(1),VFR(5),o[1],0,0,0), C0,12); \
    KRD(GL,2); GAPB(o[0]=__builtin_amdgcn_mfma_f32_32x32x16_bf16(PAF(2),VFR(2),o[0],0,0,0), C1,0); \
    KRD(GL,3); GAPB(o[1]=__builtin_amdgcn_mfma_f32_32x32x16_bf16(PAF(2),VFR(6),o[1],0,0,0), C1,4); \
    GAPB(o[0]=__builtin_amdgcn_mfma_f32_32x32x16_bf16(PAF(3),VFR(3),o[0],0,0,0), C1,8); \
    GAPB(o[1]=__builtin_amdgcn_mfma_f32_32x32x16_bf16(PAF(3),VFR(7),o[1],0,0,0), C1,12); \
    }while(0)
  int t=1;
  #undef CMASK
  #define CMASK(P0,P1,t) do{}while(0)
  for(;t+5<NT;t+=2){
    STEP(pB0,pB1,pA0,pA1,t,true,true,true);     WAIT_BAR(2); RESC(); ROT();
    STEP(pA0,pA1,pB0,pB1,t+1,true,true,true);   WAIT_BAR(2); RESC(); ROT();
  }
  #undef CMASK
  #define CMASK(P0,P1,t) do{int jb_=(t)-(NT-4); if(jb_>=0)cmask(P0,P1,jb_,qrel,hi);}while(0)
  #define ENDW(tt) do{ if((tt)+3<NT){WAIT_BAR(2);} else if((tt)+2<NT){WAIT_BAR(1);} else {WAIT_BAR(0);} }while(0)
  for(;t+1<NT;t+=2){
    STEP(pB0,pB1,pA0,pA1,t,(t+3<NT),(t+1<NT),(t+1<NT));       ENDW(t);   RESC(); ROT();
    STEP(pA0,pA1,pB0,pB1,t+1,(t+4<NT),(t+2<NT),(t+2<NT));     ENDW(t+1); RESC(); ROT();
  }
  STEP(pB0,pB1,pA0,pA1,NT-1,false,false,false); RESC();
  { float sacc=pB0[0]+pB0[1]; _Pragma("unroll") for(int r=2;r<16;++r)sacc+=pB0[r]; _Pragma("unroll") for(int r=0;r<16;++r)sacc+=pB1[r]; l_reg+=sacc;
    pw0=(u32x4){PKW(pB0,0),PKW(pB0,2),PKW(pB0,4),PKW(pB0,6)};pw1=(u32x4){PKW(pB0,8),PKW(pB0,10),PKW(pB0,12),PKW(pB0,14)};pw2=(u32x4){PKW(pB1,0),PKW(pB1,2),PKW(pB1,4),PKW(pB1,6)};pw3=(u32x4){PKW(pB1,8),PKW(pB1,10),PKW(pB1,12),PKW(pB1,14)};
    SBAR(); pv(o,vb0+sl_cur,PAF(0),PAF(1),PAF(2),PAF(3)); }
  #undef PKW
  #undef PAF
  #undef VFR
  #undef PIN
  #undef MX3
  #undef GAPA
  #undef GAPB
  #undef EX
  #undef VRD
  #undef KRD
  #undef STEP
  #undef ENDW
  {auto rr=__builtin_amdgcn_permlane32_swap(__float_as_uint(l_reg),__float_as_uint(l_reg),false,false);l_reg=__uint_as_float(rr[0])+__uint_as_float(rr[1]);}
  const int le=olane(),r32e=le&31,hie=le>>5;
  if(hie==0)wsf[32+r32e]=l_reg;asm volatile("s_waitcnt lgkmcnt(0)":::"memory");
  float rli[16];
  #pragma unroll
  for(int r=0;r<16;++r)rli[r]=__builtin_amdgcn_rcpf(wsf[32+crow(r,hie)]);
  bf16*Ow=Oc+(rowbase+q0+wid*QBLK)*OP;
  { bf16*stg=(bf16*)(shm+LDS_OST)+wid*2048;
    #pragma unroll
    for(int r=0;r<16;++r){const int orow=crow(r,hie);
      #pragma unroll
      for(int d0=0;d0<2;++d0)stg[orow*64+d0*32+r32e]=__float2bfloat16(o[d0][r]*rli[r]);}
    asm volatile("s_waitcnt lgkmcnt(0)":::"memory");
    #pragma unroll
    for(int i=0;i<4;++i){const int row=i*8+(le>>3),ch=le&7; const u32x4 v=*(const u32x4*)(stg+row*64+ch*8); ATTN_STORE16(Ow+(long)row*OP+ch*8,v);} }
  asm volatile("s_waitcnt lgkmcnt(0)\n\ts_barrier":::"memory");
  #undef DMA_K
  #undef DMA_V
  #undef CMASK
  #undef START
  #undef RESC
  #undef ROT
}
constexpr int ATTN_LDS_BYTES=LDS_BYTES;
#undef SBAR
#undef WAIT_BAR
}
namespace attn_body {
#define SBAR() __builtin_amdgcn_sched_barrier(0)
#define WAIT_BAR(N) asm volatile("s_waitcnt vmcnt(" #N ") lgkmcnt(0)\n\ts_barrier":::"memory")
constexpr int KSLOT=8192, VSLOT=16384;
constexpr int L2_K=0, L2_V=NSLOT*KSLOT, L2_WS=L2_V+NSLOT*VSLOT, L2_OST=L2_WS+NW*64*4, L2_BYTES=L2_OST+NW*4096;
constexpr int L2_PRE=L2_V+2*VSLOT, L2_PRE_WAVE=6144;
static_assert(L2_PRE+NW*L2_PRE_WAVE<=L2_BYTES,"prologue side-job scratch");
template<class Pre,class Post,class Comb> __device__ __forceinline__ void attn_unit2(const int wid,long rowbase,int qb,const bf16*Qc,const bf16*__restrict__ Kc,const bf16*__restrict__ Vc,bf16*Oc,char*shm,const Pre&pre,const Post&post,const bool pre_dma,const bf16*__restrict__ Kn,const Comb&cmb){
  const int lane=olane(),r32=lane&31,hi=lane>>5;
  typename Pre::Regs prg;
  const int q0=qb*QB;
  const bf16*Qw=Qc+(rowbase+q0+wid*QBLK)*QP;
  const bf16*Kh=Kc+rowbase*KP,*Vh=Vc+rowbase*VP;
  const unsigned lds0=(unsigned)(uintptr_t)shm;
  float*wsf=(float*)(shm+L2_WS)+wid*64;
  const bf16*ksrc=Kh+(long)lane*KP+wid*8;
  const bf16*vsrc=Vh+(long)(16*(wid&3)+(lane>>2))*VP+(wid>>2)*32+(lane&3)*8;
  const unsigned kdst=lds0+L2_K+wid*1024, vdst=lds0+L2_V+wid*1024;
  #define DMA_K(t,ks) glds16(ksrc+(long)(t)*KVBLK*KP,(unsigned)__builtin_amdgcn_readfirstlane(kdst+(ks)))
  #define DMA_V(t,ks) do{ glds16(vsrc+(long)(t)*KVBLK*VP,(unsigned)__builtin_amdgcn_readfirstlane(vdst+2*(ks))); glds16(vsrc+(long)(t)*KVBLK*VP+64,(unsigned)__builtin_amdgcn_readfirstlane(vdst+2*(ks)+8192)); }while(0)
  const char*Kbase=shm+L2_K; bf16x8 kf[8];
  const lds_cptr shm3=(lds_cptr)shm; const lds_cptr kp0=shm3+L2_K+hi*1024+r32*16; const lds_cptr vp0=shm3+L2_V+((lane>>4)&1)*32+(lane&3)*8+(4*hi+((lane&15)>>2))*64;
  const int NT=(q0+QB)/KVBLK;
  if(!pre_dma){DMA_K(0,0);DMA_V(0,0);DMA_K(1,KSLOT);}
  bf16x8 qr[4];
  #pragma unroll
  for(int d0=0;d0<4;++d0)qr[d0]=*reinterpret_cast<const bf16x8*>(&Qw[(long)r32*QP+d0*16+hi*8]);
  float l_reg=0.f;f32x16 o[4];o[0]=f32x16{};o[1]=f32x16{};o[2]=f32x16{};o[3]=f32x16{};const f32x16 zc=f32x16{};
  const int qrel=wid*QBLK+r32;
  f32x16 C0,C1;
  s16x4 vlo[8],vhi[8]; u32x4 pw0,pw1,pw2,pw3;
  int sl_prev=0,sl_cur=0,sl_next=KSLOT;
  #define ROT() do{sl_prev=sl_cur;sl_cur=sl_next;sl_next=(sl_next==(NSLOT-1)*KSLOT)?0:sl_next+KSLOT;}while(0)
  #define PKW(P,B) cvtpk_s(P[B],P[B+1])
  #define PAF(k) __builtin_bit_cast(bf16x8,pw##k)
  #define VFR(i) (bf16x8){vlo[i][0],vlo[i][1],vlo[i][2],vlo[i][3],vhi[i][0],vhi[i][1],vhi[i][2],vhi[i][3]}
  #define PIN(x) asm volatile("":"+v"(x))
  #define EX(v) __builtin_amdgcn_exp2f(v)
  #define VRD(H,i) do{ vlo[i]=vtr(vp_+((2*(H)+((i)>>2))*4096+((i)&3)*1024)); vhi[i]=vtr(vp_+((2*(H)+((i)>>2))*4096+((i)&3)*1024+512)); }while(0)
  typedef float f32x2p __attribute__((ext_vector_type(2)));
  #define PACK(PW,P,B) do{ sacc+=(f32x2p){P[B],P[B+1]}; sacc+=(f32x2p){P[B+2],P[B+3]}; sacc+=(f32x2p){P[B+4],P[B+5]}; sacc+=(f32x2p){P[B+6],P[B+7]}; PIN(sacc); \
      PW[0]=PKW(P,B); PW[1]=PKW(P,B+2); PW[2]=PKW(P,B+4); PW[3]=PKW(P,B+6); PIN(PW); }while(0)
  if(!pre_dma){DMA_K(2,2*KSLOT);}
  pre.issue(prg,lane);
  const bool pact=pre.active();
  if(pact){WAIT_BAR(20);}else{WAIT_BAR(0);}
  qkt(C0,C1,Kbase,qr,zc,r32,hi);
  { const int jb_=0-(NT-4); if(jb_>=0)cmask(C0,C1,jb_,qrel,hi); }
  #pragma unroll
  for(int r=0;r<16;++r){C0[r]=EX(C0[r]);C1[r]=EX(C1[r]);}
  { f32x2p sacc={0.f,0.f}; PACK(pw0,C0,0); PACK(pw1,C0,8); PACK(pw2,C1,0); PACK(pw3,C1,8); l_reg+=sacc.x+sacc.y; }
  pre.finish(prg,(__attribute__((address_space(3))) unsigned char*)(shm3+L2_PRE+wid*L2_PRE_WAVE),lane);
  if(pact){WAIT_BAR(4);}else{WAIT_BAR(0);}
  DMA_K(3,0);DMA_V(1,KSLOT);
  ROT();
  kload8(kf,kp0+sl_cur);
  if(pact){WAIT_BAR(7);}else{WAIT_BAR(3);}
  auto STEP=[&](auto band_,const int t) __attribute__((always_inline)) {
    constexpr bool BAND=decltype(band_)::value;
    const bool gk=BAND?(t+3<NT):true, gv=BAND?(t+1<NT):true;
    const lds_cptr vp_=vp0+2*sl_prev;
    SBAR();
    if constexpr(BAND){ const int jb_=t-(NT-4); bandfill(C0,wid*QBLK-64*jb_,r32,hi); bandfill(C1,wid*QBLK-64*jb_-32,r32,hi); }
    VRD(0,0); SBAR(); if constexpr(BAND){C0=__builtin_amdgcn_mfma_f32_32x32x16_bf16(kf[0],qr[0],C0,0,0,0);}else{C0=__builtin_amdgcn_mfma_f32_32x32x16_bf16(kf[0],qr[0],zc,0,0,0);} SBAR();
    VRD(0,4); SBAR(); if constexpr(BAND){C1=__builtin_amdgcn_mfma_f32_32x32x16_bf16(kf[1],qr[0],C1,0,0,0);}else{C1=__builtin_amdgcn_mfma_f32_32x32x16_bf16(kf[1],qr[0],zc,0,0,0);} SBAR();
    VRD(0,1); SBAR(); C0=__builtin_amdgcn_mfma_f32_32x32x16_bf16(kf[2],qr[1],C0,0,0,0); SBAR();
    VRD(0,5); SBAR(); C1=__builtin_amdgcn_mfma_f32_32x32x16_bf16(kf[3],qr[1],C1,0,0,0); SBAR();
    VRD(0,2); SBAR(); C0=__builtin_amdgcn_mfma_f32_32x32x16_bf16(kf[4],qr[2],C0,0,0,0); SBAR();
    VRD(0,6); SBAR(); C1=__builtin_amdgcn_mfma_f32_32x32x16_bf16(kf[5],qr[2],C1,0,0,0); SBAR();
    VRD(0,3); SBAR(); C0=__builtin_amdgcn_mfma_f32_32x32x16_bf16(kf[6],qr[3],C0,0,0,0); SBAR();
    VRD(0,7); SBAR(); C1=__builtin_amdgcn_mfma_f32_32x32x16_bf16(kf[7],qr[3],C1,0,0,0); SBAR();
    if(gk){DMA_K(t+3,sl_cur);} if(gv){DMA_V(t+1,sl_next);}
    SBAR();
    #define GAPB(MF,X,B,VI) do{ MF; X[B]=EX(X[B]); X[B+1]=EX(X[B+1]); X[B+2]=EX(X[B+2]); X[B+3]=EX(X[B+3]); PIN(X); VRD(1,VI); SBAR(); }while(0)
    GAPB(o[0]=__builtin_amdgcn_mfma_f32_32x32x16_bf16(PAF(0),VFR(0),o[0],0,0,0), C0,0, 0);
    GAPB(o[1]=__builtin_amdgcn_mfma_f32_32x32x16_bf16(PAF(0),VFR(4),o[1],0,0,0), C0,4, 4);
    GAPB(o[0]=__builtin_amdgcn_mfma_f32_32x32x16_bf16(PAF(1),VFR(1),o[0],0,0,0), C0,8, 1);
    GAPB(o[1]=__builtin_amdgcn_mfma_f32_32x32x16_bf16(PAF(1),VFR(5),o[1],0,0,0), C0,12,5);
    GAPB(o[0]=__builtin_amdgcn_mfma_f32_32x32x16_bf16(PAF(2),VFR(2),o[0],0,0,0), C1,0, 2);
    GAPB(o[1]=__builtin_amdgcn_mfma_f32_32x32x16_bf16(PAF(2),VFR(6),o[1],0,0,0), C1,4, 6);
    GAPB(o[0]=__builtin_amdgcn_mfma_f32_32x32x16_bf16(PAF(3),VFR(3),o[0],0,0,0), C1,8, 3);
    GAPB(o[1]=__builtin_amdgcn_mfma_f32_32x32x16_bf16(PAF(3),VFR(7),o[1],0,0,0), C1,12,7);
    #undef GAPB
    f32x2p sacc={0.f,0.f};
    o[2]=__builtin_amdgcn_mfma_f32_32x32x16_bf16(PAF(0),VFR(0),o[2],0,0,0); if(gv){kload2(kf,kp0+sl_next,0);} SBAR();
    o[3]=__builtin_amdgcn_mfma_f32_32x32x16_bf16(PAF(0),VFR(4),o[3],0,0,0); PACK(pw0,C0,0); if(gv){kload2(kf,kp0+sl_next,1);} SBAR();
    o[2]=__builtin_amdgcn_mfma_f32_32x32x16_bf16(PAF(1),VFR(1),o[2],0,0,0); if(gv){kload2(kf,kp0+sl_next,2);} SBAR();
    o[3]=__builtin_amdgcn_mfma_f32_32x32x16_bf16(PAF(1),VFR(5),o[3],0,0,0); PACK(pw1,C0,8); if(gv){kload2(kf,kp0+sl_next,3);} SBAR();
    o[2]=__builtin_amdgcn_mfma_f32_32x32x16_bf16(PAF(2),VFR(2),o[2],0,0,0); SBAR();
    o[3]=__builtin_amdgcn_mfma_f32_32x32x16_bf16(PAF(2),VFR(6),o[3],0,0,0); PACK(pw2,C1,0); SBAR();
    o[2]=__builtin_amdgcn_mfma_f32_32x32x16_bf16(PAF(3),VFR(3),o[2],0,0,0); SBAR();
    o[3]=__builtin_amdgcn_mfma_f32_32x32x16_bf16(PAF(3),VFR(7),o[3],0,0,0); PACK(pw3,C1,8); SBAR();
    l_reg+=sacc.x+sacc.y;
    if constexpr(!BAND){WAIT_BAR(3);} else { if(t+3<NT){WAIT_BAR(3);} else if(t+2<NT){WAIT_BAR(2);} else if(t+1<NT){WAIT_BAR(0);} }
    ROT();
    };
  { int t=1; for(;t<NT-4;++t)STEP(MainT{},t);
    const int tend=NT-(wid<2?2:(wid<4?1:0));
    for(;t<tend;++t)STEP(BandT{},t);
    for(;t<NT;++t){ if(t+3<NT){DMA_K(t+3,sl_cur);} if(t+1<NT){DMA_V(t+1,sl_next);}
      if(t+3<NT){WAIT_BAR(3);} else if(t+2<NT){WAIT_BAR(2);} else if(t+1<NT){WAIT_BAR(0);}
      ROT(); } }
  typename Post::Regs pq; post.prefetch(pq,wid*64+lane);
  if(wid>=6){ const int vb=(int)(lds0+L2_V)+((lane>>4)&1)*32+(lane&3)*8+(4*hi+((lane&15)>>2))*64+2*sl_prev;
    SBAR(); pv(o,vb,PAF(0),PAF(1),PAF(2),PAF(3)); pv(o+2,vb+8192,PAF(0),PAF(1),PAF(2),PAF(3)); }
  asm volatile("s_waitcnt lgkmcnt(0)\n\ts_barrier":::"memory");
  if(Kn){ const bf16*ksn=Kn+rowbase*KP+(long)lane*KP+wid*8;
    glds16(ksn,(unsigned)__builtin_amdgcn_readfirstlane(kdst)); DMA_V(0,0); glds16(ksn+(long)KVBLK*KP,(unsigned)__builtin_amdgcn_readfirstlane(kdst+KSLOT)); glds16(ksn+(long)2*KVBLK*KP,(unsigned)__builtin_amdgcn_readfirstlane(kdst+2*KSLOT)); }
  #undef PKW
  #undef PAF
  #undef VFR
  #undef PIN
  #undef EX
  #undef VRD
  #undef PACK
  {auto rr=__builtin_amdgcn_permlane32_swap(__float_as_uint(l_reg),__float_as_uint(l_reg),false,false);l_reg=__uint_as_float(rr[0])+__uint_as_float(rr[1]);}
  const int le=olane(),r32e=le&31,hie=le>>5;
  if(hie==0)wsf[32+r32e]=l_reg;asm volatile("s_waitcnt lgkmcnt(0)":::"memory");
  float rli[16];
  #pragma unroll
  for(int r=0;r<16;++r)rli[r]=__builtin_amdgcn_rcpf(wsf[32+crow(r,hie)]);
  bf16*Ow=Oc+(rowbase+q0+wid*QBLK)*OP;
  bf16*stg=(bf16*)(shm+L2_OST)+wid*2048;
  const long trow0=rowbase+q0+wid*QBLK;
  if(cmb.on){
    typename Comb::Regs cr; cmb.prefetch(cr,trow0,le);
    u32x4 o1v[2][4];
    #pragma unroll
    for(int hf=0;hf<2;++hf){
      #pragma unroll
      for(int r=0;r<16;++r){const int orow=crow(r,hie);
        #pragma unroll
        for(int d0=0;d0<2;++d0)stg[orow*64+d0*32+r32e]=__float2bfloat16(o[2*hf+d0][r]*rli[r]);}
      asm volatile("s_waitcnt lgkmcnt(0)":::"memory");
      #pragma unroll
      for(int i=0;i<4;++i){const int row=i*8+(le>>3),ch=le&7; o1v[hf][i]=*(const u32x4*)(stg+row*64+ch*8);}
      asm volatile("s_waitcnt lgkmcnt(0)":::"memory");
    }
    cmb.finish(cr,o1v,trow0,le);
  }else{
  #pragma unroll
  for(int hf=0;hf<2;++hf){
    #pragma unroll
    for(int r=0;r<16;++r){const int orow=crow(r,hie);
      #pragma unroll
      for(int d0=0;d0<2;++d0)stg[orow*64+d0*32+r32e]=__float2bfloat16(o[2*hf+d0][r]*rli[r]);}
    asm volatile("s_waitcnt lgkmcnt(0)":::"memory");
    #pragma unroll
    for(int i=0;i<4;++i){const int row=i*8+(le>>3),ch=le&7; const u32x4 v=*(const u32x4*)(stg+row*64+ch*8); ATTN_STORE16(Ow+(long)row*OP+hf*64+ch*8,v);}
    asm volatile("s_waitcnt lgkmcnt(0)":::"memory");
  }
  }
  asm volatile("s_waitcnt lgkmcnt(0)\n\ts_barrier":::"memory");
  post.run(pq,wid,le);
  #undef DMA_K
  #undef DMA_V
  #undef ROT
}
constexpr int ATTN2_LDS_BYTES=L2_BYTES;
#undef SBAR
#undef WAIT_BAR
}
constexpr int NWAVES = 8;
constexpr int NPH = 8;
#ifndef MK_N_LAUNCHES
#define MK_N_LAUNCHES 1
#endif
constexpr int N_LAUNCHES = MK_N_LAUNCHES;
static_assert(N_LAUNCHES == 1 || N_LAUNCHES == NPH, "MK_N_LAUNCHES is 1 or 8");

constexpr int BATCH = 16, SEQ = 2048, T = BATCH * SEQ, D = 1024, INC = 2560, NE = 32, FF = 512, ECAP = T;
constexpr float RMS_EPS = 1e-6f;
constexpr float LAMBDA_INIT = 0.2f;

constexpr size_t MiB = 1u << 20;
constexpr size_t WS_CTL = 0, CTL_ZERO_BYTES = 65536;
constexpr size_t WS_DUMP = 1 * MiB + 512 * 1024;
constexpr size_t WS_WIN = 2 * MiB;
constexpr size_t WS_WOUT = 7 * MiB;
constexpr size_t WS_WR = 9 * MiB;
constexpr size_t WS_SGW = 10 * MiB;
constexpr size_t WS_ROPE = 11 * MiB;
constexpr size_t WS_RSTD1 = 13 * MiB;
constexpr size_t WS_RSTD2 = 13 * MiB + 512 * 1024;
constexpr size_t WS_SVST = 14 * MiB;
constexpr size_t WS_HST = 16 * MiB;
constexpr size_t WS_ELIST = 18 * MiB;
constexpr size_t WS_PGATE = 22 * MiB;
constexpr size_t WS_W1 = 24 * MiB;
constexpr size_t WS_EVALS = 56 * MiB;
constexpr size_t WS_W2 = 88 * MiB;
constexpr size_t WS_XB = 120 * MiB;
constexpr size_t WS_Q = 184 * MiB, WS_K = 216 * MiB, WS_V = 248 * MiB, WS_SU = 280 * MiB, WS_SV = 312 * MiB;
constexpr size_t WS_Y = 184 * MiB;
constexpr size_t WS_MIX = 344 * MiB;
constexpr size_t WS_HB = 408 * MiB;
constexpr size_t WS_H8 = 472 * MiB;
constexpr size_t WS_END = 504 * MiB;
constexpr int CW_TMO = 0, CW_CODE = 1;
constexpr int CW_BAR = 4096;
constexpr int CW_Q7 = 2048;
constexpr int CW_GRP = 12288;
constexpr int CW_XID = 14848;
constexpr int CW_CNT = 8192;
static_assert((CW_CNT + 64 * NE) * 4 <= (int)CTL_ZERO_BYTES && CW_GRP + 64 * 40 <= CW_XID && (CW_XID + 256) * 4 <= (int)CTL_ZERO_BYTES, "CTL words inside the memset region");

constexpr int RING_OFF = 0, RING_BYTES = 131072;
constexpr int LCTL_OFF = RING_BYTES;
constexpr int L_MISC = LCTL_OFF, L_TSTART = LCTL_OFF + 64, L_RSTART = LCTL_OFF + 256, L_CNT = LCTL_OFF + 448, L_HIST = LCTL_OFF + 576, L_BASE = LCTL_OFF + 704;
constexpr int L_ULIST = LCTL_OFF + 1024;
constexpr int L_ROWTAB = LCTL_OFF + 2048;
constexpr int LDS_BYTES = 147456;
#define GAS __attribute__((address_space(1)))
#define LAS __attribute__((address_space(3)))
typedef unsigned short bf16;
typedef unsigned v4u __attribute__((ext_vector_type(4)));
typedef float f32x4 __attribute__((ext_vector_type(4)));
typedef short bf16x8 __attribute__((ext_vector_type(8)));
typedef GAS unsigned gu32;
typedef GAS unsigned long long gu64;
#define RLX_AGENT __ATOMIC_RELAXED, __HIP_MEMORY_SCOPE_AGENT
#define LDS_WAIT() asm volatile("s_waitcnt lgkmcnt(0)" ::: "memory")
#define VM_WAIT() asm volatile("s_waitcnt vmcnt(0)" ::: "memory")
__device__ __forceinline__ unsigned long long rt() { return __builtin_amdgcn_s_memrealtime(); }
__device__ __forceinline__ unsigned f2bf(float f) { unsigned u = __builtin_bit_cast(unsigned, f); return (u + 0x7fffu + ((u >> 16) & 1u)) >> 16; }
__device__ __forceinline__ unsigned pk2(float lo, float hi) { return f2bf(lo) | (f2bf(hi) << 16); }

#define XB_TMO      128
#define XB_XCNT(j)  (256  + 64 * (j))
#define XB_XSUB(j)  (1280 + 64 * (j))
#define XB_XGEN(j)  (2304 + 64 * (j))
#define XB_TOP      3328
#define XB_TOPGEN   3392
#define XCD_BAR_WORDS 3456
#define XB_SPIN_CAP (1u << 18)

__device__ __forceinline__ unsigned xb_ld(unsigned* p)              { return __hip_atomic_load(p, __ATOMIC_RELAXED, __HIP_MEMORY_SCOPE_AGENT); }
__device__ __forceinline__ unsigned xb_add(unsigned* p, unsigned v) { return __hip_atomic_fetch_add(p, v, __ATOMIC_RELAXED, __HIP_MEMORY_SCOPE_AGENT); }
__device__ __forceinline__ unsigned xb_xcc_id() { return (unsigned)__builtin_amdgcn_s_getreg((3 << 11) | 20) & 0xFu; }
#define XB_SPIN(cond, bar) do { unsigned _sp = 0; while (cond) { __builtin_amdgcn_s_sleep(1); \
    if ((++_sp & 255u) == 0u) { if (xb_ld(&(bar)[XB_TMO])) break; if (_sp > XB_SPIN_CAP) { atomicAdd(&(bar)[XB_TMO], 1u); break; } } } } while (0)

struct XcdBarrier {
    unsigned* bar; unsigned x;
    volatile LAS unsigned* st;
};

__device__ __forceinline__ XcdBarrier xcd_barrier_post(unsigned* bar, volatile LAS unsigned* st, const bool t0  ) {
    XcdBarrier b; b.bar = bar; b.x = xb_xcc_id(); b.st = st;
    if (t0) (void)xb_add(&bar[XB_XCNT(b.x)], 1u);
    return b;
}
__device__ __forceinline__ void xcd_barrier_complete(unsigned* bar, unsigned x, unsigned& nloc, unsigned& nx) {
    const unsigned G = gridDim.x * gridDim.y * gridDim.z;
    unsigned sum, cnt, mine, sp = 0u;
    for (;;) {
        sum = 0u; cnt = 0u; mine = 0u;
#pragma unroll
        for (unsigned j = 0; j < 16; ++j) { const unsigned c = xb_ld(&bar[XB_XCNT(j)]); sum += c; cnt += (c > 0u) ? 1u : 0u; mine = (j == x) ? c : mine; }
        if (sum == G) break;
        __builtin_amdgcn_s_sleep(1);
        if ((++sp & 255u) == 0u) { if (xb_ld(&bar[XB_TMO])) break; if (sp > XB_SPIN_CAP) { atomicAdd(&bar[XB_TMO], 1u); break; } }
    }
    nloc = mine > 0u ? mine : 1u; nx = cnt > 0u ? cnt : 1u;
}

__device__ __forceinline__ void xcd_barrier(const XcdBarrier& b, const bool t0  ) {
    asm volatile("s_waitcnt vmcnt(0)" ::: "memory");
    __syncthreads();
    if (t0) {
        unsigned* bar = b.bar;
        __builtin_amdgcn_s_waitcnt(0);
        unsigned nloc = b.st[0], nx = b.st[1];
        if (nloc == 0u) { xcd_barrier_complete(bar, b.x, nloc, nx); b.st[0] = nloc; b.st[1] = nx; }
        const unsigned old = xb_add(&bar[XB_XSUB(b.x)], 1u);
        const unsigned gen = old / nloc;
        if (old + 1u == (gen + 1u) * nloc) {
            __builtin_amdgcn_fence(__ATOMIC_RELEASE, "agent");
            asm volatile("s_waitcnt vmcnt(0)" ::: "memory");
            const unsigned og = xb_add(&bar[XB_TOP], 1u);
            const unsigned tg = og / nx;
            if (og + 1u == (tg + 1u) * nx) xb_add(&bar[XB_TOPGEN], 1u);
            else XB_SPIN(xb_ld(&bar[XB_TOPGEN]) == tg, bar);
            __builtin_amdgcn_fence(__ATOMIC_ACQUIRE, "agent");
            xb_add(&bar[XB_XGEN(b.x)], 1u);
            asm volatile("s_waitcnt vmcnt(0)" ::: "memory");
        } else {
            XB_SPIN(xb_ld(&bar[XB_XGEN(b.x)]) == gen, bar);
            __builtin_amdgcn_fence(__ATOMIC_ACQUIRE, "agent");
            asm volatile("s_waitcnt vmcnt(0)" ::: "memory");
        }
    }
    __syncthreads();
}
__device__ __forceinline__ void grp_barrier(unsigned* bar, unsigned* word, const unsigned target, const bool same, const bool t0) {
    asm volatile("s_waitcnt vmcnt(0)" ::: "memory");
    __syncthreads();
    if (t0) {
        __builtin_amdgcn_s_waitcnt(0);
        if (!same) { __builtin_amdgcn_fence(__ATOMIC_RELEASE, "agent"); asm volatile("s_waitcnt vmcnt(0)" ::: "memory"); }
        (void)xb_add(word, 1u);
        XB_SPIN(xb_ld(word) < target, bar);
        __builtin_amdgcn_fence(__ATOMIC_ACQUIRE, "agent");
        asm volatile("s_waitcnt vmcnt(0)" ::: "memory");
    }
    __syncthreads();
}
#ifndef PROBE_PHASE
#define PROBE_PHASE -1
#endif
typedef unsigned u32x2_t __attribute__((ext_vector_type(2)));
typedef float f32x2_t __attribute__((ext_vector_type(2)));
struct InvFreq { float f[8]; };
struct Args { const float* in[25]; float* out; unsigned char* ws; InvFreq ifq; int ph_lo, ph_hi; };
struct Frame {
    LAS unsigned char* lds;
    gu32* ctl;
    int wave;
    int vcu, G;
    int grp;
    int gx, gr, gp;
    float* out; unsigned char* ws;
};
#ifndef SGU_IN_ATTN
#define SGU_IN_ATTN 0
#endif
#ifndef DYN_P7
#define DYN_P7 0
#endif
#ifndef USE_NT
#define USE_NT 1
#endif
#if USE_NT
#define NT_LOAD(p) __builtin_nontemporal_load(p)
#define NT_STORE(v, p) __builtin_nontemporal_store(v, p)
#else
#define NT_LOAD(p) (*(p))
#define NT_STORE(v, p) (*(p) = (v))
#endif
__device__ __forceinline__ int olane() { int l; asm volatile("v_mbcnt_lo_u32_b32 %0, -1, 0\n\tv_mbcnt_hi_u32_b32 %0, -1, %0" : "=v"(l)); return l; }
#define otid() (F.wave * 64 + olane())
template <int MASK> __device__ __forceinline__ float sxor(float v) { return __builtin_bit_cast(float, __builtin_amdgcn_ds_swizzle(__builtin_bit_cast(int, v), (MASK << 10) | 0x1f)); }
__device__ __forceinline__ float sum32(float v) { auto r = __builtin_amdgcn_permlane32_swap(__float_as_uint(v), __float_as_uint(v), false, false); return __uint_as_float(r[0]) + __uint_as_float(r[1]); }
__device__ __forceinline__ float wave_sum(float v) { v += sxor<1>(v); v += sxor<2>(v); v += sxor<4>(v); v += sxor<8>(v); v += sxor<16>(v); return sum32(v); }
__device__ __forceinline__ float bflo(unsigned w) { return __uint_as_float(w << 16); }
__device__ __forceinline__ float bfhi(unsigned w) { return __uint_as_float(w & 0xffff0000u); }
__device__ __forceinline__ unsigned cvtpk(float lo, float hi) { return pg8::cvt_pk_bf16(lo, hi); }

struct RmIn  { __device__ __forceinline__ int operator()(int n) const { const int G = n >> 6, lc = n & 63, fq = lc >> 4, bj = (lc >> 3) & 1, e = lc & 7, pn = G >> 2, wc = G & 3; return 256 * pn + 128 * bj + 32 * wc + 8 * fq + e; } };
struct RmId  { __device__ __forceinline__ int operator()(int n) const { return n; } };
struct RmGU  { int add; __device__ __forceinline__ int operator()(int f) const { return (f >> 7) * 256 + add + (f & 127); } };
struct P0Item { const float* W; const float* gk; bf16* WT; int N, Kd, k0, n0, kind, add; float f8s; };
constexpr int P0_I_IN = (D / 64) * (INC / 64), P0_I_OUT = (D / 64) * (D / 64), P0_I_GU = (D / 64) * (FF / 64), P0_I_DN = (FF / 64) * (D / 64);
constexpr int P0_NITEMS = P0_I_IN + P0_I_OUT;
constexpr int W1_NITEMS = NE * 2 * P0_I_GU, W2_NITEMS = NE * P0_I_DN;
__device__ __forceinline__ P0Item p0_decode(const Args& A, unsigned char* ws, int it) {
    P0Item d; int r = it;
    if (r < P0_I_IN) { d.W = A.in[3]; d.gk = A.in[2]; d.WT = (bf16*)(ws + WS_WIN); d.N = INC; d.Kd = D; d.kind = 3; d.add = 0; d.f8s = 0.f; }
    else if ((r -= P0_I_IN) < P0_I_OUT) { d.W = A.in[16]; d.gk = nullptr; d.WT = (bf16*)(ws + WS_WOUT); d.N = D; d.Kd = D; d.kind = 1; d.add = 0; d.f8s = 0.f; }
    else { d.W = nullptr; d.gk = nullptr; d.WT = nullptr; d.N = 64; d.Kd = 0; d.kind = 1; d.add = 0; d.f8s = 0.f; }
    const int nblk = d.N / 64; d.k0 = 64 * (r / nblk); d.n0 = 64 * (r % nblk); return d;
}
__device__ __forceinline__ P0Item decode_w1(const Args& A, unsigned char* ws, int r) {
    P0Item d; const int e = r >> 8, q = r & 255, up = q >> 7, rr = q & 127;
    d.W = (up ? A.in[23] : A.in[22]) + (size_t)e * D * FF; d.gk = A.in[17]; d.WT = (bf16*)(ws + WS_W1 + (size_t)e * 1024 * 1024); d.N = FF; d.Kd = D; d.kind = 2; d.add = up ? 128 : 0; d.f8s = pg8::W1_SCALE;
    d.k0 = 64 * (rr >> 3); d.n0 = 64 * (rr & 7); return d;
}
__device__ __forceinline__ P0Item decode_w2(const Args& A, unsigned char* ws, int r) {
    P0Item d; const int e = r >> 7, rr = r & 127;
    d.W = A.in[24] + (size_t)e * FF * D; d.gk = nullptr; d.WT = (bf16*)(ws + WS_W2 + (size_t)e * 1024 * 512); d.N = D; d.Kd = FF; d.kind = 0  ; d.add = 0; d.f8s = pg8::W2_SCALE;
    d.k0 = 64 * (rr >> 4); d.n0 = 64 * (rr & 15); return d;
}
__device__ __forceinline__ int p0_rowmap(int kind, int add, int n) {
    if (kind == 0) { const int G = n >> 6, lc = n & 63, fq = lc >> 4, bj = (lc >> 3) & 1, e = lc & 7, pn = G >> 2, wc = G & 3; return 256 * pn + 128 * bj + 32 * wc + 8 * fq + e; }
    if (kind == 1) return n;
    if (kind == 3) { const int G = n >> 6, lc = n & 63, bj = lc >> 5, fq = (lc >> 3) & 3, e = lc & 7, pn = G >> 2, wc = G & 3; return 256 * pn + 128 * bj + 32 * wc + 8 * fq + e; }
    return (n >> 7) * 256 + add + (n & 127);
}
__device__ __forceinline__ void p0_load(const P0Item& d, f32x4 (&v)[16], f32x4 (&g)[4], int lane) {
    const int kr = lane >> 4, nc = lane & 15;
    const float* src = d.W + (size_t)(d.k0 + 16 * kr) * d.N + d.n0 + 4 * nc;
#pragma unroll
    for (int i = 0; i < 16; ++i) v[i] = NT_LOAD((const GAS f32x4*)(src + (size_t)i * d.N));
#pragma unroll
    for (int i = 0; i < 4; ++i) g[i] = d.gk ? *(const GAS f32x4*)(d.gk + d.k0 + 16 * kr + 4 * i) : (f32x4){1.f, 1.f, 1.f, 1.f};
}
__device__ __forceinline__ void p0_store(const P0Item& d, const f32x4 (&v)[16], const f32x4 (&g)[4], LAS unsigned char* scr, int lane) {
    const int kr = lane >> 4, nc = lane & 15;
    if (d.f8s != 0.f) {
        const float sc = d.f8s;
#pragma unroll
        for (int q = 0; q < 4; ++q) { v4u w;
            w.x = pg8::pk4_fp8(v[0][q] * g[0][0] * sc, v[1][q] * g[0][1] * sc, v[2][q] * g[0][2] * sc, v[3][q] * g[0][3] * sc); w.y = pg8::pk4_fp8(v[4][q] * g[1][0] * sc, v[5][q] * g[1][1] * sc, v[6][q] * g[1][2] * sc, v[7][q] * g[1][3] * sc);
            w.z = pg8::pk4_fp8(v[8][q] * g[2][0] * sc, v[9][q] * g[2][1] * sc, v[10][q] * g[2][2] * sc, v[11][q] * g[2][3] * sc); w.w = pg8::pk4_fp8(v[12][q] * g[3][0] * sc, v[13][q] * g[3][1] * sc, v[14][q] * g[3][2] * sc, v[15][q] * g[3][3] * sc);
            *(LAS v4u*)(scr + (4 * nc + q) * 80 + 16 * kr) = w; }
        LDS_WAIT(); asm volatile("" ::: "memory");
        unsigned char* W8 = (unsigned char*)d.WT;
#pragma unroll
        for (int j = 0; j < 4; ++j) { const int p = lane + 64 * j, n = p >> 2, c = p & 3; const v4u x = *(const LAS v4u*)(scr + n * 80 + 16 * c);
            NT_STORE(x, (GAS v4u*)(W8 + (size_t)p0_rowmap(d.kind, d.add, d.n0 + n) * d.Kd + d.k0 + 16 * c)); }
        LDS_WAIT(); asm volatile("" ::: "memory");
        return;
    }
#pragma unroll
    for (int q = 0; q < 4; ++q) { v4u w0, w1;
        w0.x = cvtpk(v[0][q] * g[0][0], v[1][q] * g[0][1]); w0.y = cvtpk(v[2][q] * g[0][2], v[3][q] * g[0][3]); w0.z = cvtpk(v[4][q] * g[1][0], v[5][q] * g[1][1]); w0.w = cvtpk(v[6][q] * g[1][2], v[7][q] * g[1][3]);
        w1.x = cvtpk(v[8][q] * g[2][0], v[9][q] * g[2][1]); w1.y = cvtpk(v[10][q] * g[2][2], v[11][q] * g[2][3]); w1.z = cvtpk(v[12][q] * g[3][0], v[13][q] * g[3][1]); w1.w = cvtpk(v[14][q] * g[3][2], v[15][q] * g[3][3]);
        LAS unsigned char* p = scr + (4 * nc + q) * 144 + 32 * kr; *(LAS v4u*)p = w0; *(LAS v4u*)(p + 16) = w1; }
    LDS_WAIT(); asm volatile("" ::: "memory");
    const int c = lane & 7;
#pragma unroll
    for (int j = 0; j < 8; ++j) { const int n = (lane >> 3) + 8 * j; const v4u x = *(const LAS v4u*)(scr + n * 144 + 16 * c);
        *(GAS v4u*)(d.WT + (size_t)p0_rowmap(d.kind, d.add, d.n0 + n) * d.Kd + d.k0 + 8 * c) = x; }
    LDS_WAIT(); asm volatile("" ::: "memory");
}
template <int WHICH> __device__ __forceinline__ P0Item conv_decode(const Args& A, unsigned char* ws, int it) { if (WHICH == 0) return p0_decode(A, ws, it); if (WHICH == 1) return decode_w1(A, ws, it); return decode_w2(A, ws, it); }
template <int WHICH> __device__ __forceinline__ void conv_items(const Args& A, unsigned char* ws, int it0, int stride, int nitems, LAS unsigned char* sc8, int lane) {
    f32x4 va[16], ga[4], vb[16], gb[4]; P0Item da, db;
    int it = it0;
    if (it < nitems) { da = conv_decode<WHICH>(A, ws, it); p0_load(da, va, ga, lane); }
    while (it < nitems) {
        const bool hb_ = it + stride < nitems;
        if (hb_) { db = conv_decode<WHICH>(A, ws, it + stride); p0_load(db, vb, gb, lane); }
        p0_store(da, va, ga, sc8, lane);
        if (!hb_) break;
        const bool ha_ = it + 2 * stride < nitems;
        if (ha_) { da = conv_decode<WHICH>(A, ws, it + 2 * stride); p0_load(da, va, ga, lane); }
        p0_store(db, vb, gb, sc8, lane);
        if (!ha_) break;
        it += 2 * stride;
    }
}
struct ConvPre {
    struct Regs { f32x4 v[16], g[4]; };
    const Args* A; unsigned char* ws; int idx;
    __device__ __forceinline__ constexpr bool active() const { return true; }
    __device__ __forceinline__ void issue(Regs& r, int lane) const { const P0Item d = decode_w1(*A, ws, idx); p0_load(d, r.v, r.g, lane); }
    __device__ __forceinline__ void finish(const Regs& r, LAS unsigned char* scr, int lane) const { const P0Item d = decode_w1(*A, ws, idx); p0_store(d, r.v, r.g, scr, lane); }
};
__device__ __forceinline__ void sincos_acc(float ang, float& s, float& c) {
    const double a = (double)ang, kq = __builtin_rint(a * 0.63661977236758134308), r = a - kq * 1.57079632679489661923;
    const float rf = (float)r, z = rf * rf;
    const float sp = rf + rf * z * (-1.6666654611e-1f + z * (8.3321608736e-3f + z * (-1.9515295891e-4f)));
    const float cp = 1.0f - 0.5f * z + z * z * (4.166664568298827e-2f + z * (-1.388731625493765e-3f + z * 2.443315711809948e-5f));
    const int q = ((int)kq) & 3;
    s = (q == 0) ? sp : (q == 1) ? cp : (q == 2) ? -sp : -cp;
    c = (q == 0) ? cp : (q == 1) ? -sp : (q == 2) ? -cp : sp;
}
__device__ __forceinline__ void p0_prologue(Frame& F, const Args& A) {
    LAS float* scr = (LAS float*)(F.lds + RING_OFF + F.wave * 16384);
    const int lane = otid() & 63;
    const int gw = F.vcu * NWAVES + F.wave, NGW = F.G * NWAVES;
    unsigned char* ws = F.ws;
    for (int r50_ = 0; r50_ < (PROBE_PHASE == 50 ? 2 : 1); ++r50_)
    { const float* x = A.in[0]; bf16* XB = (bf16*)(ws + WS_XB); float* rstd1 = (float*)(ws + WS_RSTD1);
      for (int m = gw; m < T; m += 2 * NGW) {
        const int m2 = (m + NGW < T) ? m + NGW : m;
        const GAS f32x4* xr = (const GAS f32x4*)(x + (size_t)m * D) + lane; const GAS f32x4* xr2 = (const GAS f32x4*)(x + (size_t)m2 * D) + lane;
        f32x4 v[4], w[4]; float s2 = 0.f, t2 = 0.f;
#pragma unroll
        for (int j = 0; j < 4; ++j) { v[j] = NT_LOAD(xr + 64 * j); w[j] = NT_LOAD(xr2 + 64 * j); }
#pragma unroll
        for (int j = 0; j < 4; ++j) { s2 += (v[j].x * v[j].x + v[j].y * v[j].y) + (v[j].z * v[j].z + v[j].w * v[j].w); t2 += (w[j].x * w[j].x + w[j].y * w[j].y) + (w[j].z * w[j].z + w[j].w * w[j].w); }
        const float rs = 1.0f / sqrtf(wave_sum(s2) * (1.f / D) + RMS_EPS), rt2 = 1.0f / sqrtf(wave_sum(t2) * (1.f / D) + RMS_EPS);
        GAS u32x2_t* o8 = (GAS u32x2_t*)(XB + (size_t)m * D) + lane; GAS u32x2_t* p8 = (GAS u32x2_t*)(XB + (size_t)m2 * D) + lane;
#pragma unroll
        for (int j = 0; j < 4; ++j) { o8[64 * j] = (u32x2_t){cvtpk(v[j].x, v[j].y), cvtpk(v[j].z, v[j].w)}; p8[64 * j] = (u32x2_t){cvtpk(w[j].x, w[j].y), cvtpk(w[j].z, w[j].w)}; }
        if (lane == 0) { rstd1[m] = rs; rstd1[m2] = rt2; }
      } }
    for (int r51_ = 0; r51_ < (PROBE_PHASE == 51 ? 2 : 1); ++r51_) conv_items<0>(A, ws, F.wave * F.G + F.vcu, NGW, P0_NITEMS, (LAS unsigned char*)scr, lane);
    const int gt = gw * 64 + olane(), NGT = NGW * 64;
    { bf16* WR = (bf16*)(ws + WS_WR); const float* g = A.in[17]; const float* wg = A.in[18]; const float* we = A.in[20];
      for (int i = gt; i < 48 * 1024; i += NGT) { const int j = i >> 10, k = i & 1023; float v = 0.f; if (j < 32) v = we[k * 32 + j] * g[k]; else if (j < 36) v = wg[k * 4 + (j - 32)] * g[k]; WR[i] = (bf16)f2bf(v); } }
    { bf16* SGW = (bf16*)(ws + WS_SGW); const float* w = A.in[13];
      for (int i = gt; i < 4 * 128 * 128; i += NGT) { const int t = (i >> 7) & 127, s = i & 127; SGW[i] = (bf16)f2bf(s <= t ? w[i] : 0.f); }
      float* RW = (float*)(ws + WS_SGW + 131072);
      for (int i = gw; i < 4 * 128; i += NGW) { const int t = i & 127, l_ = olane(); const float a = wave_sum((l_ <= t ? w[i * 128 + l_] : 0.f) + (l_ + 64 <= t ? w[i * 128 + 64 + l_] : 0.f)); if (l_ == 0) RW[i] = a; } }
    { float* rope = (float*)(ws + WS_ROPE); const int* pos = (const int*)A.in[1];
      for (int i = gt; i < T * 8; i += NGT) { const int m = i >> 3, j = i & 7; const float ang = (float)pos[m] * A.ifq.f[j]; float s, c; sincos_acc(ang, s, c); rope[m * 16 + j] = c; rope[m * 16 + 8 + j] = s; } }
}

__device__ __forceinline__ void attn_combine(long tok0, int h, const bf16* Oraw, bf16* mix, const float* g, float lam) {
    const int lane = olane();
    asm volatile("s_waitcnt vmcnt(0)" ::: "memory");
    const int ch = lane & 7;
    f32x4 g0a = *(const f32x4*)(g + ch * 8), g0b = *(const f32x4*)(g + ch * 8 + 4), g1a = *(const f32x4*)(g + 64 + ch * 8), g1b = *(const f32x4*)(g + 64 + ch * 8 + 4);
#pragma unroll
    for (int i = 0; i < 4; ++i) {
        const long tok = tok0 + i * 8 + (lane >> 3);
        const bf16* src = Oraw + tok * 1024 + h * 256 + ch * 8;
        const v4u a00 = *(const GAS v4u*)(src), a01 = *(const GAS v4u*)(src + 64), a10 = *(const GAS v4u*)(src + 128), a11 = *(const GAS v4u*)(src + 192);
        float d0[8], d1[8]; float ss = 0.f;
#pragma unroll
        for (int j = 0; j < 4; ++j) {
            d0[2 * j] = bflo(a00[j]) - lam * bflo(a10[j]); d0[2 * j + 1] = bfhi(a00[j]) - lam * bfhi(a10[j]);
            d1[2 * j] = bflo(a01[j]) - lam * bflo(a11[j]); d1[2 * j + 1] = bfhi(a01[j]) - lam * bfhi(a11[j]);
            ss += d0[2 * j] * d0[2 * j] + d0[2 * j + 1] * d0[2 * j + 1] + d1[2 * j] * d1[2 * j] + d1[2 * j + 1] * d1[2 * j + 1]; }
        ss += sxor<1>(ss); ss += sxor<2>(ss); ss += sxor<4>(ss);
        const float rn = (1.0f - LAMBDA_INIT) / sqrtf(ss * (1.0f / 128.0f) + RMS_EPS);
        v4u o0, o1;
        o0.x = cvtpk(d0[0] * rn * g0a[0], d0[1] * rn * g0a[1]); o0.y = cvtpk(d0[2] * rn * g0a[2], d0[3] * rn * g0a[3]); o0.z = cvtpk(d0[4] * rn * g0b[0], d0[5] * rn * g0b[1]); o0.w = cvtpk(d0[6] * rn * g0b[2], d0[7] * rn * g0b[3]);
        o1.x = cvtpk(d1[0] * rn * g1a[0], d1[1] * rn * g1a[1]); o1.y = cvtpk(d1[2] * rn * g1a[2], d1[3] * rn * g1a[3]); o1.z = cvtpk(d1[4] * rn * g1b[0], d1[5] * rn * g1b[1]); o1.w = cvtpk(d1[6] * rn * g1b[2], d1[7] * rn * g1b[3]);
        bf16* dst = mix + tok * 1024 + h * 128 + ch * 8;
        *(GAS v4u*)dst = o0; *(GAS v4u*)(dst + 64) = o1;
    }
}
struct CombFuse {
    struct Regs { v4u a0[4][2]; f32x4 g0a, g0b, g1a, g1b; };
    bool on; const bf16* O0; bf16* mix; const float* g; float lam; int h;
    __device__ __forceinline__ void prefetch(Regs& r, long trow0, int le) const { const int ch = le & 7;
#pragma unroll
        for (int i = 0; i < 4; ++i) { const bf16* src = O0 + (trow0 + i * 8 + (le >> 3)) * 1024 + h * 256 + ch * 8; r.a0[i][0] = *(const GAS v4u*)(src); r.a0[i][1] = *(const GAS v4u*)(src + 64); }
        r.g0a = *(const f32x4*)(g + ch * 8); r.g0b = *(const f32x4*)(g + ch * 8 + 4); r.g1a = *(const f32x4*)(g + 64 + ch * 8); r.g1b = *(const f32x4*)(g + 64 + ch * 8 + 4); }
    template <class V> __device__ __forceinline__ void finish(const Regs& r, const V (&o1v)[2][4], long trow0, int le) const { const int ch = le & 7;
#pragma unroll
        for (int i = 0; i < 4; ++i) { const long tok = trow0 + i * 8 + (le >> 3);
            const v4u a00 = r.a0[i][0], a01 = r.a0[i][1], a10 = __builtin_bit_cast(v4u, o1v[0][i]), a11 = __builtin_bit_cast(v4u, o1v[1][i]);
            float d0[8], d1[8]; float ss = 0.f;
#pragma unroll
            for (int j = 0; j < 4; ++j) {
                d0[2 * j] = bflo(a00[j]) - lam * bflo(a10[j]); d0[2 * j + 1] = bfhi(a00[j]) - lam * bfhi(a10[j]);
                d1[2 * j] = bflo(a01[j]) - lam * bflo(a11[j]); d1[2 * j + 1] = bfhi(a01[j]) - lam * bfhi(a11[j]);
                ss += d0[2 * j] * d0[2 * j] + d0[2 * j + 1] * d0[2 * j + 1] + d1[2 * j] * d1[2 * j] + d1[2 * j + 1] * d1[2 * j + 1]; }
            ss += sxor<1>(ss); ss += sxor<2>(ss); ss += sxor<4>(ss);
            const float rn = (1.0f - LAMBDA_INIT) * __builtin_amdgcn_rsqf(ss * (1.0f / 128.0f) + RMS_EPS);
            v4u q0_, q1_;
            q0_.x = cvtpk(d0[0] * rn * r.g0a[0], d0[1] * rn * r.g0a[1]); q0_.y = cvtpk(d0[2] * rn * r.g0a[2], d0[3] * rn * r.g0a[3]); q0_.z = cvtpk(d0[4] * rn * r.g0b[0], d0[5] * rn * r.g0b[1]); q0_.w = cvtpk(d0[6] * rn * r.g0b[2], d0[7] * rn * r.g0b[3]);
            q1_.x = cvtpk(d1[0] * rn * r.g1a[0], d1[1] * rn * r.g1a[1]); q1_.y = cvtpk(d1[2] * rn * r.g1a[2], d1[3] * rn * r.g1a[3]); q1_.z = cvtpk(d1[4] * rn * r.g1b[0], d1[5] * rn * r.g1b[1]); q1_.w = cvtpk(d1[6] * rn * r.g1b[2], d1[7] * rn * r.g1b[3]);
            bf16* dst = mix + tok * 1024 + h * 128 + ch * 8;
            *(GAS v4u*)dst = q0_; *(GAS v4u*)(dst + 64) = q1_; } }
};
struct SguPre { f32x4 st[4]; v4u sv[4]; v4u uw[4]; };
__device__ __forceinline__ void sgu_prefetch(SguPre& P, unsigned char* ws, int u, int tid) {
    const int b = u >> 6, c = (u >> 2) & 15, g = u & 3, s = tid >> 2, seg = tid & 3; const long tok = (long)b * SEQ + c * 128 + s;
    { const int lane_ = tid & 63, wid_ = tid >> 6; const bf16* up = (const bf16*)(ws + WS_SU) + ((long)b * SEQ + c * 128 + 16 * wid_ + (lane_ & 15)) * 512 + g * 128 + 8 * (lane_ >> 4);
#pragma unroll
      for (int a = 0; a < 4; ++a) P.uw[a] = *(const GAS v4u*)(up + 32 * a); }
    const float* st = (const float*)(ws + WS_SVST) + tok * 16; const bf16* src = (const bf16*)(ws + WS_SV) + tok * 512 + g * 128 + seg * 8;
#pragma unroll
    for (int i = 0; i < 4; ++i) P.st[i] = *(const GAS f32x4*)(st + 4 * i);
#pragma unroll
    for (int j = 0; j < 4; ++j) P.sv[j] = *(const GAS v4u*)(src + 32 * j);
}
__device__ __forceinline__ void p2_sgu(Frame& F, const Args& A) {
    constexpr int VP = 136;
    LAS unsigned short* vnT = (LAS unsigned short*)(F.lds + RING_OFF);
    unsigned char* ws = F.ws;
    const int tid = otid(), lane = tid & 63, wid = F.wave, fr = lane & 15, fq = lane >> 4;
    const int NU = BATCH * 16 * 4;
    const int gs_ = F.gr < 4 ? F.gr : 7 - F.gr, gb_ = 2 * F.gx + (F.gr >= 4 ? 1 : 0);
    auto unit_of = [&](int k) -> int { if (!F.grp) return F.vcu + k * F.G; const int c = k < 2 ? 2 * gs_ + k : 14 - 2 * gs_ + (k - 2); return (gb_ << 6) | (c << 2) | F.gp; };
    int uk = 0;
    int u = unit_of(0); if (u >= NU) return;
    SguPre P; sgu_prefetch(P, ws, u, tid);
    const int t = 16 * wid + fr, nks = (wid >> 1) + 1;
    int gcur = -1; f32x4 ga[8], cb[8]; bf16x8 wf[4];
    for (;;) {
        const int b = u >> 6, c = (u >> 2) & 15, g = u & 3;
        if (g != gcur) { gcur = g;
            const float* lg = A.in[11] + g * 128 + 8 * fq; const float* lb = A.in[12] + g * 128 + 8 * fq;
            const float bs = A.in[14][g * 128 + t], rw = ((const float*)(ws + WS_SGW + 131072))[g * 128 + t];
#pragma unroll
            for (int i = 0; i < 8; ++i) { const int co = 32 * (i >> 1) + 4 * (i & 1); ga[i] = *(const GAS f32x4*)(lg + co); cb[i] = *(const GAS f32x4*)(lb + co) * rw + bs; }
            const bf16* Wg = (const bf16*)(ws + WS_SGW) + g * 16384 + t * 128 + 8 * fq;
#pragma unroll
            for (int ks = 0; ks < 4; ++ks) wf[ks] = *(const GAS bf16x8*)(Wg + 32 * (ks < nks ? ks : 0)); }
        { const int s = tid >> 2, seg = tid & 3; float sum = 0.f, sq = 0.f;
#pragma unroll
          for (int i = 0; i < 4; ++i) { sum += P.st[i].x + P.st[i].z; sq += P.st[i].y + P.st[i].w; }
          const float mean = sum * (1.0f / 512.0f), var = sq * (1.0f / 512.0f) - mean * mean, rstd = __builtin_amdgcn_rsqf(var + RMS_EPS);
#pragma unroll
          for (int j = 0; j < 4; ++j)
#pragma unroll
            for (int e = 0; e < 8; ++e) { const unsigned w = P.sv[j][e >> 1]; const float xv = (e & 1) ? bfhi(w) : bflo(w); const int d = 32 * j + 8 * seg + e;
                vnT[(32 * j + 16 * (e >> 2) + 4 * seg + (e & 3)) * VP + s] = (unsigned short)f2bf((xv - mean) * rstd); (void)d; } }
        const long tok = (long)b * SEQ + c * 128 + t;
        u32x2_t uw[8];
#pragma unroll
        for (int a = 0; a < 4; ++a) { uw[2 * a] = (u32x2_t){P.uw[a].x, P.uw[a].y}; uw[2 * a + 1] = (u32x2_t){P.uw[a].z, P.uw[a].w}; }
        __syncthreads();
        const int un = unit_of(uk + 1); const bool more = F.grp ? (uk + 1 < 4) : (un < NU);
        if (more) sgu_prefetch(P, ws, un, tid);
        f32x4 acc[8];
#pragma unroll
        for (int i = 0; i < 8; ++i) acc[i] = (f32x4){0.f, 0.f, 0.f, 0.f};
#pragma unroll
        for (int ks = 0; ks < 4; ++ks) if (ks < nks) {
#pragma unroll
            for (int i = 0; i < 8; ++i) { const bf16x8 xf = *(const LAS bf16x8*)(vnT + (16 * i + fr) * VP + 32 * ks + 8 * fq);
                acc[i] = __builtin_amdgcn_mfma_f32_16x16x32_bf16(xf, wf[ks], acc[i], 0, 0, 0); } }
        const float* og = A.in[15] + g * 128 + 8 * fq; f32x4 gv[8];
#pragma unroll
        for (int i = 0; i < 8; ++i) gv[i] = *(const GAS f32x4*)(og + 32 * (i >> 1) + 4 * (i & 1));
        float sg[8][4]; float ss = 0.f;
#pragma unroll
        for (int i = 0; i < 8; ++i) {
            const pg8::f32x2 u01 = pg8::gelu_pk((pg8::f32x2){bflo(uw[i].x), bfhi(uw[i].x)}), u23 = pg8::gelu_pk((pg8::f32x2){bflo(uw[i].y), bfhi(uw[i].y)});
            sg[i][0] = u01.x * (ga[i].x * acc[i][0] + cb[i].x); sg[i][1] = u01.y * (ga[i].y * acc[i][1] + cb[i].y);
            sg[i][2] = u23.x * (ga[i].z * acc[i][2] + cb[i].z); sg[i][3] = u23.y * (ga[i].w * acc[i][3] + cb[i].w);
            ss += (sg[i][0] * sg[i][0] + sg[i][1] * sg[i][1]) + (sg[i][2] * sg[i][2] + sg[i][3] * sg[i][3]); }
        ss += sxor<16>(ss); ss = sum32(ss);
        const float rn = __builtin_amdgcn_rsqf(ss * (1.0f / 128.0f) + RMS_EPS);
        bf16* mp = (bf16*)(ws + WS_MIX) + tok * 1024 + 512 + g * 128 + 8 * fq;
#pragma unroll
        for (int a = 0; a < 4; ++a) { const int i0 = 2 * a, i1 = 2 * a + 1;
            *(GAS v4u*)(mp + 32 * a) = (v4u){cvtpk(sg[i0][0] * rn * gv[i0].x, sg[i0][1] * rn * gv[i0].y), cvtpk(sg[i0][2] * rn * gv[i0].z, sg[i0][3] * rn * gv[i0].w),
                                             cvtpk(sg[i1][0] * rn * gv[i1].x, sg[i1][1] * rn * gv[i1].y), cvtpk(sg[i1][2] * rn * gv[i1].z, sg[i1][3] * rn * gv[i1].w)}; }
        __syncthreads();
        if (!more) break;
        u = un; ++uk;
    }
}
struct NoPost { struct Regs {}; __device__ __forceinline__ void prefetch(Regs&, int) const {} __device__ __forceinline__ void run(const Regs&, int, int) const {} };
__device__ __forceinline__ void p2_mixers(Frame& F, const Args& A, const int part  ) {
    unsigned char* ws = F.ws;
    const int l0 = otid() & 63;
    const float lam = __builtin_bit_cast(float, __builtin_amdgcn_readfirstlane(__builtin_bit_cast(int, expf(wave_sum(A.in[6][l0] * A.in[7][l0])) - expf(wave_sum(A.in[8][l0] * A.in[9][l0])) + LAMBDA_INIT)));
    const attn_body::bf16* Q = (const attn_body::bf16*)(ws + WS_Q); const attn_body::bf16* Kt = (const attn_body::bf16*)(ws + WS_K); const attn_body::bf16* V = (const attn_body::bf16*)(ws + WS_V);
    attn_body::bf16* Oraw = (attn_body::bf16*)(ws + WS_HB);
    const bool sgu_first = F.grp && (F.gp & 1);
    if (sgu_first) p2_sgu(F, A);
    if (part != 2)
    for (int rA_ = 0; rA_ < (PROBE_PHASE == 20 ? 2 : 1); ++rA_)
    for (int it = F.vcu; it < 256; it += F.G) {
        int bh = it >> 2, s = it & 3, b = bh >> 2, h = bh & 3;
        if (F.grp) { s = F.gr < 4 ? F.gr : 7 - F.gr; b = 2 * F.gx + (F.gr >= 4 ? 1 : 0); h = F.gp; }
        for (int j = 0; j < 4; ++j) {
            const int qb = (j < 2) ? 7 - s : s, m = j & 1;
            const int cidx = ((it * 4 + j) * NWAVES) + F.wave; static_assert(256 * 4 * NWAVES == W1_NITEMS, "one gate/up item per (item, sub-pass, wave)"); const ConvPre pre{&A, ws, cidx};
            const NoPost post{};
            attn_body::attn_unit2(F.wave, (long)b * SEQ, qb, Q + (h * 2 + m) * 64, Kt + (h * 2 + m) * 64, V + h * 128, Oraw + (h * 2 + m) * 128, (char*)(F.lds + RING_OFF), pre, post, j > 0, j < 3 ? Kt + (h * 2 + ((j + 1) & 1)) * 64 : nullptr,
                                      CombFuse{m == 1, (const bf16*)(ws + WS_HB), (bf16*)(ws + WS_MIX), A.in[10], lam, h});

        }
    }
    if (part != 1 && !sgu_first)
    for (int rS_ = 0; rS_ < (PROBE_PHASE == 21 ? 2 : 1); ++rS_) p2_sgu(F, A);
}

__device__ __forceinline__ void p4_stage_weights_dma(Frame& F) {
    const int lane = olane(); const bf16* WR = (const bf16*)(F.ws + WS_WR);
#pragma unroll
    for (int i = 0; i < 12; ++i) { const int q = F.wave * 12 + i, row = q >> 1, half = q & 1;
        __builtin_amdgcn_global_load_lds((const unsigned*)(WR + row * 1024 + half * 512 + lane * 8), (LAS unsigned*)(F.lds + RING_OFF + row * 2064 + half * 1024), 16, 0, 0); }
}
__device__ __forceinline__ void p4_router(Frame& F, const Args& A, const bool prestaged) {
    unsigned char* ws = F.ws;
    const int tid = otid(), lane = tid & 63, wid = F.wave, fr = lane & 15, fq = lane >> 4;
    constexpr int WPITCH = 2064;
    LAS unsigned char* wl = F.lds + RING_OFF;
    LAS float* lg = (LAS float*)(F.lds + RING_OFF + 102400) + wid * (16 * 49);
    LAS unsigned* hist = (LAS unsigned*)(F.lds + L_HIST); LAS unsigned* base = (LAS unsigned*)(F.lds + L_BASE);
    const bf16* HB = (const bf16*)(ws + WS_HB); const bf16* WR = (const bf16*)(ws + WS_WR);
    const float* hst = (const float*)(ws + WS_HST); float* rstd2 = (float*)(ws + WS_RSTD2);
    int* elist = (int*)(ws + WS_ELIST); f32x2_t* evals = (f32x2_t*)(ws + WS_EVALS);
    bool staged = prestaged;
    for (int blk = F.grp ? 2 * (16 * F.gx + 8 * (F.gp >> 1) + F.gr) + (F.gp & 1) : F.vcu; blk < T / 128; blk += F.grp ? T : F.G) {
        if (tid < 32) hist[tid] = 0u;
        __syncthreads();
        const int tok0 = blk * 128 + wid * 16;
        f32x4 acc[3];
        f32x4 hsq[4];
        bf16x8 y[32];
        for (int rr_ = 0; rr_ < (PROBE_PHASE == 4 ? 2 : 1); ++rr_) {
#pragma unroll
        for (int n = 0; n < 3; ++n) acc[n] = (f32x4){0.f, 0.f, 0.f, 0.f};
        const bf16* hp = HB + (size_t)(tok0 + fr) * 1024 + 16 * fq;
#pragma unroll
        for (int ks = 0; ks < 32; ++ks) y[ks] = *(const GAS bf16x8*)(hp + 64 * (ks >> 1) + 8 * (ks & 1));
        { const float* hs = hst + (size_t)(tok0 + fr) * 16;
#pragma unroll
          for (int i = 0; i < 4; ++i) hsq[i] = *(const GAS f32x4*)(hs + 4 * i); }
        if (!staged) { staged = true;
            for (int p = tid; p < 48 * 128; p += NWAVES * 64) { const int row = p >> 7, c = p & 127; *(LAS v4u*)(wl + row * WPITCH + c * 16) = *(const GAS v4u*)(WR + row * 1024 + c * 8); }
            __syncthreads(); }
        const LAS unsigned char* wp = wl + fr * WPITCH + 32 * fq;
#pragma unroll
        for (int ks = 0; ks < 32; ++ks) {
#pragma unroll
            for (int n = 0; n < 3; ++n) { const bf16x8 xf = *(const LAS bf16x8*)(wp + n * 16 * WPITCH + 128 * (ks >> 1) + 16 * (ks & 1)); acc[n] = __builtin_amdgcn_mfma_f32_16x16x32_bf16(xf, y[ks], acc[n], 0, 0, 0); }
        }
        asm volatile("" ::: "memory"); }
        float rs; { float s = 0.f;
#pragma unroll
            for (int i = 0; i < 4; ++i) { const f32x4 p = hsq[i]; s += (p.x + p.y) + (p.z + p.w); }
            rs = __builtin_amdgcn_rsqf(s * (1.0f / 1024.0f) + RMS_EPS); if (fq == 0) rstd2[tok0 + fr] = rs; }
#pragma unroll
        for (int n = 0; n < 3; ++n)
#pragma unroll
            for (int r = 0; r < 4; ++r) { const int j = 16 * n + 4 * fq + r; float bias = 0.f; if (j < 32) bias = A.in[21][j]; else if (j < 36) bias = A.in[19][j - 32];
                lg[fr * 49 + j] = acc[n][r] * rs + bias; }
        LDS_WAIT(); asm volatile("" ::: "memory");
        int e1 = 0, e2 = 0; unsigned l1 = 0, l2 = 0; float g1 = 0.f, g2 = 0.f;
        if (lane < 16) {
            const LAS float* L = lg + lane * 49;
            float gm = L[32]; int grp = 0;
#pragma unroll
            for (int i = 1; i < 4; ++i) { const float v = L[32 + i]; if (v > gm) { gm = v; grp = i; } }
            float Z = 0.f;
#pragma unroll
            for (int i = 0; i < 4; ++i) Z += __builtin_amdgcn_exp2f((L[32 + i] - gm) * 1.4426950408889634f);
            const float pg = 1.0f / Z;
            float el[8];
#pragma unroll
            for (int i = 0; i < 8; ++i) el[i] = L[grp * 8 + i];
            float v1 = el[0]; int i1 = 0;
#pragma unroll
            for (int i = 1; i < 8; ++i) if (el[i] > v1) { v1 = el[i]; i1 = i; }
            float v2 = -INFINITY; int i2 = 0;
#pragma unroll
            for (int i = 0; i < 8; ++i) if (i != i1 && el[i] > v2) { v2 = el[i]; i2 = i; }
            const float s1 = __builtin_amdgcn_rcpf(1.0f + __builtin_amdgcn_exp2f((v2 - v1) * 1.4426950408889634f));
            g1 = pg * s1; g2 = pg * (1.0f - s1); e1 = grp * 8 + i1; e2 = grp * 8 + i2;
            l1 = __hip_atomic_fetch_add(&hist[e1], 1u, __ATOMIC_RELAXED, __HIP_MEMORY_SCOPE_WORKGROUP); l2 = __hip_atomic_fetch_add(&hist[e2], 1u, __ATOMIC_RELAXED, __HIP_MEMORY_SCOPE_WORKGROUP);
        }
        __syncthreads();
        unsigned bv_ = 0u; if (tid < 32) bv_ = __hip_atomic_fetch_add((unsigned*)(F.ctl + CW_CNT + 64 * tid), hist[tid], __ATOMIC_RELAXED, __HIP_MEMORY_SCOPE_AGENT);
        { unsigned char* h8p = ws + WS_H8 + (size_t)(tok0 + fr) * 1024 + 16 * fq;
#pragma unroll
          for (int t = 0; t < 16; ++t) { const v4u w = __builtin_bit_cast(v4u, y[2 * t]), z = __builtin_bit_cast(v4u, y[2 * t + 1]);
              NT_STORE(((v4u){pg8::pk4_fp8(bflo(w.x) * pg8::H8_SCALE, bfhi(w.x) * pg8::H8_SCALE, bflo(w.y) * pg8::H8_SCALE, bfhi(w.y) * pg8::H8_SCALE),
                                                pg8::pk4_fp8(bflo(w.z) * pg8::H8_SCALE, bfhi(w.z) * pg8::H8_SCALE, bflo(w.w) * pg8::H8_SCALE, bfhi(w.w) * pg8::H8_SCALE),
                                                pg8::pk4_fp8(bflo(z.x) * pg8::H8_SCALE, bfhi(z.x) * pg8::H8_SCALE, bflo(z.y) * pg8::H8_SCALE, bfhi(z.y) * pg8::H8_SCALE),
                                                pg8::pk4_fp8(bflo(z.z) * pg8::H8_SCALE, bfhi(z.z) * pg8::H8_SCALE, bflo(z.w) * pg8::H8_SCALE, bfhi(z.w) * pg8::H8_SCALE)}), (GAS v4u*)(h8p + 64 * t)); } }
        if (tid < 32) base[tid] = bv_;
        __syncthreads();
        if (lane < 16) { const int tok = tok0 + lane;
            const size_t i1 = (size_t)e1 * ECAP + base[e1] + l1, i2 = (size_t)e2 * ECAP + base[e2] + l2;
            elist[i1] = 2 * tok; evals[i1] = (f32x2_t){rs, g1}; elist[i2] = 2 * tok + 1; evals[i2] = (f32x2_t){rs, g2}; }
        __syncthreads();
    }
}

__device__ __forceinline__ void moe_tables(Frame& F, int reps) {
    LAS int* ts = (LAS int*)(F.lds + L_TSTART); LAS int* rs = (LAS int*)(F.lds + L_RSTART); LAS int* cn = (LAS int*)(F.lds + L_CNT); LAS int* ul = (LAS int*)(F.lds + L_ULIST);
    const int tid = otid();
    if (tid < 32) cn[tid] = (int)__hip_atomic_load((unsigned*)(F.ctl + CW_CNT + 64 * tid), __ATOMIC_RELAXED, __HIP_MEMORY_SCOPE_AGENT);
    __syncthreads();
    if (tid < 64) { const int e = tid & 31, c = cn[e]; const unsigned v = ((unsigned)((c + 255) >> 8) << 20) | (unsigned)c; unsigned incl = v;
#pragma unroll
        for (int d = 1; d < 32; d <<= 1) { const unsigned up = (unsigned)__builtin_amdgcn_ds_bpermute(((tid - d) & 63) * 4, (int)incl); if (e >= d) incl += up; }
        const unsigned excl = incl - v;
        if (tid < 32) { ts[e] = (int)(excl >> 20); rs[e] = (int)(excl & 0xfffffu); if (e == 31) { ts[NE] = (int)(incl >> 20); rs[NE] = (int)(incl & 0xfffffu); } } }
    __syncthreads();
    if (tid < 16) { const int total = ts[NE] * 4; int L = tid * F.G + F.vcu; int e = -1, rt = 0, ct = 0;
        if (L < total * reps) { if (L >= total) L -= total;
            const int rtg = L >> 2; ct = L & 3; e = 0; for (int k = 1; k < NE; ++k) if (rtg >= ts[k]) e = k; rt = rtg - ts[e]; }
        ul[tid * 8 + 0] = e; ul[tid * 8 + 1] = rt; ul[tid * 8 + 2] = ct; ul[tid * 8 + 3] = e >= 0 ? min(256, cn[e] - rt * 256) : 0; ul[tid * 8 + 4] = e >= 0 ? rs[e] + rt * 256 : 0; }
    __syncthreads();
}
template <int VS> struct MoeOrder {
    const LAS int* ul; const int* elist; const float* evals; const LAS unsigned char* rowtab;
    static constexpr bool ROWREC = true; static constexpr int VALSEL = VS;
    __device__ __forceinline__ bool next(int i, pg8::Unit& u) const {
        if (i >= 16) return false;
        const int e = __builtin_amdgcn_readfirstlane(ul[i * 8 + 0]); if (e < 0) return false;
        const int rt = __builtin_amdgcn_readfirstlane(ul[i * 8 + 1]), ct = __builtin_amdgcn_readfirstlane(ul[i * 8 + 2]);
        u.e = e; u.pm = rt; u.pn = ct; u.nvalid = __builtin_amdgcn_readfirstlane(ul[i * 8 + 3]); u.arow = __builtin_amdgcn_readfirstlane(ul[i * 8 + 4]);
        u.lst = elist + (size_t)e * ECAP + rt * 256; u.vals = evals + ((size_t)e * ECAP + rt * 256) * 2; u.brow = e * 1024 + ct * 256; return true;
    }
};

__device__ __forceinline__ void p7_combine(Frame& F) {
    const int gw = F.vcu * NWAVES + F.wave, NGW = F.G * NWAVES, lane = olane();
    const unsigned char* Y = F.ws + WS_Y; const bf16* HB = (const bf16*)(F.ws + WS_HB);
    typedef float f32x2v __attribute__((ext_vector_type(2)));
    for (int m = gw; m < T; m += NGW) {
        GAS f32x4* o = (GAS f32x4*)(F.out + (size_t)m * D) + lane;
        const GAS u32x2_t* hp = (const GAS u32x2_t*)(HB + (size_t)m * D) + lane;
        const GAS unsigned* y0 = (const GAS unsigned*)(Y + (size_t)(2 * m) * D) + lane; const GAS unsigned* y1 = (const GAS unsigned*)(Y + (size_t)(2 * m + 1) * D) + lane;
        u32x2_t h[4]; unsigned a[4], b[4];
#pragma unroll
        for (int j = 0; j < 4; ++j) { h[j] = NT_LOAD(hp + 64 * j); a[j] = NT_LOAD(y0 + 64 * j); b[j] = NT_LOAD(y1 + 64 * j); }
#pragma unroll
        for (int j = 0; j < 4; ++j) {
            const f32x2v a0 = __builtin_amdgcn_cvt_pk_f32_fp8((int)a[j], false), a1 = __builtin_amdgcn_cvt_pk_f32_fp8((int)a[j], true);
            const f32x2v b0 = __builtin_amdgcn_cvt_pk_f32_fp8((int)b[j], false), b1 = __builtin_amdgcn_cvt_pk_f32_fp8((int)b[j], true);
            f32x4 r; r.x = bflo(h[j].x) + (a0.x + b0.x) * (1.0f / pg8::Y8_SCALE); r.y = bfhi(h[j].x) + (a0.y + b0.y) * (1.0f / pg8::Y8_SCALE);
            r.z = bflo(h[j].y) + (a1.x + b1.x) * (1.0f / pg8::Y8_SCALE); r.w = bfhi(h[j].y) + (a1.y + b1.y) * (1.0f / pg8::Y8_SCALE);
            NT_STORE(r, o + 64 * j); }
    }
}

__global__ void __launch_bounds__(NWAVES * 64, 2) hymba_fwd(Args args) {
    extern __shared__ __attribute__((aligned(16))) unsigned char lds[];
    Frame F;
    F.lds = (LAS unsigned char*)lds;
    F.wave = __builtin_amdgcn_readfirstlane((int)threadIdx.x >> 6);
    F.G = gridDim.x; { const int bx = blockIdx.x; F.vcu = (F.G % 8 == 0) ? (bx % 8) * (F.G / 8) + bx / 8 : bx; }
    unsigned char* ws = args.ws; F.ws = ws; F.out = args.out;
    F.ctl = (gu32*)(ws + WS_CTL);
    F.grp = (N_LAUNCHES == 1 && F.G == 256 && PROBE_PHASE < 0) ? 1 : 0; F.gx = (int)blockIdx.x & 7; F.gr = ((int)blockIdx.x >> 3) & 7; F.gp = (int)blockIdx.x >> 6;
    for (int u = threadIdx.x; u < (LDS_BYTES - LCTL_OFF) / 4; u += NWAVES * 64) ((LAS unsigned*)(F.lds + LCTL_OFF))[u] = 0u;
    __syncthreads();
    XcdBarrier bar; bar.bar = (unsigned*)(F.ctl + CW_BAR); bar.x = 0; bar.st = nullptr;
    if (N_LAUNCHES == 1) bar = xcd_barrier_post((unsigned*)(F.ctl + CW_BAR), (volatile LAS unsigned*)(F.lds + L_MISC), threadIdx.x == 0);
    if (F.grp && threadIdx.x == 0) __hip_atomic_store((unsigned*)(F.ctl + CW_XID + blockIdx.x), xb_xcc_id() + 1u, __ATOMIC_RELAXED, __HIP_MEMORY_SCOPE_AGENT);
    const int lo = args.ph_lo, hi = args.ph_hi;
#define IN(k) (lo <= (k) && (k) < hi)
#ifndef PROBE_PHASE
#define PROBE_PHASE -1
#endif
#ifndef PROBE_MODE
#define PROBE_MODE 0
#endif
#define REPS(k) for (int rep_ = 0; rep_ < ((k) == PROBE_PHASE ? 2 : 1); ++rep_)
#define SEAM(k) do { if (IN(k) && IN((k) + 1)) { if (PROBE_PHASE == 32) { asm volatile("s_waitcnt vmcnt(0)" ::: "memory"); if (F.wave == 0 && olane() == 0) __builtin_amdgcn_fence(__ATOMIC_RELEASE, "agent"); } xcd_barrier(bar, F.wave == 0 && olane() == 0); if (PROBE_PHASE == 30) { xcd_barrier(bar, F.wave == 0 && olane() == 0); xcd_barrier(bar, F.wave == 0 && olane() == 0); } } } while (0)

    if (IN(0)) REPS(0) { p0_prologue(F, args); } SEAM(0);
    unsigned* gword = (unsigned*)(F.ctl + CW_GRP + 64 * (4 * F.gx + (F.gr < 4 ? F.gr : 7 - F.gr)));
    unsigned* xword = (unsigned*)(F.ctl + CW_GRP + 64 * (32 + F.gx));
    if (F.grp && threadIdx.x == 0) { const unsigned mine = xb_xcc_id() + 1u; unsigned same8 = 1u, same32 = 1u; const int s_ = F.gr < 4 ? F.gr : 7 - F.gr;
        for (int k = 0; k < 32; ++k) { const int r_ = k & 7, p_ = k >> 3; const bool eq = xb_ld((unsigned*)(F.ctl + CW_XID + F.gx + 8 * r_ + 64 * p_)) == mine;
            if (!eq) { same32 = 0u; if (r_ == s_ || r_ == 7 - s_) same8 = 0u; } }
        ((volatile LAS unsigned*)(F.lds + L_MISC))[4] = same8; ((volatile LAS unsigned*)(F.lds + L_MISC))[5] = same32; }
#ifndef STAG1
#define STAG1 0
#endif
#ifndef STAG3
#define STAG3 0
#endif
#define STAGGER(n) do { if (F.vcu & 1) { for (int s_ = 0; s_ < (n); ++s_) __builtin_amdgcn_s_sleep(20); } } while (0)
    if (IN(1)) REPS(1) {
        STAGGER(STAG1);
        pg8::Gemm g{(const pg8::bf16_t*)(ws + WS_XB), (const pg8::bf16_t*)(ws + WS_WIN), D};
        pg8::StaticOrderT<T / 256, INC / 256> S; S.init(F.G, (int)blockIdx.x);
        pg8::EpiInProj E{(pg8::bf16_t*)(ws + WS_Q), (pg8::bf16_t*)(ws + WS_K), (pg8::bf16_t*)(ws + WS_V), (pg8::bf16_t*)(ws + WS_SU), (pg8::bf16_t*)(ws + WS_SV),
                         (const float*)(ws + WS_RSTD1), (const float*)(ws + WS_ROPE), args.in[4], args.in[5], (float*)(ws + WS_SVST), (PROBE_PHASE == 1 && rep_ == 1) ? PROBE_MODE : 0};
        pg8::gemm_phase<pg8::EpiInProj, pg8::StaticOrderT<T / 256, INC / 256>, false>(F.lds + RING_OFF, g, S, E, F.wave);
    } if (F.grp) { grp_barrier((unsigned*)(F.ctl + CW_BAR), xword, 32u, ((volatile LAS unsigned*)(F.lds + L_MISC))[5] != 0u, threadIdx.x == 0); } else SEAM(1);
#define GSEAM(k, tgt) do { if (F.grp) { grp_barrier((unsigned*)(F.ctl + CW_BAR), gword, (tgt), ((volatile LAS unsigned*)(F.lds + L_MISC))[4] != 0u, threadIdx.x == 0); } else SEAM(k); } while (0)
    if (IN(2)) REPS(2) {
        if (PROBE_PHASE == 31) { p2_mixers(F, args, 1); xcd_barrier(bar, F.wave == 0 && olane() == 0); p2_mixers(F, args, 2); }
        else p2_mixers(F, args, 0);
    } GSEAM(2, 8u);
    if (IN(3)) REPS(3) {
        STAGGER(STAG3);
        pg8::Gemm g{(const pg8::bf16_t*)(ws + WS_MIX), (const pg8::bf16_t*)(ws + WS_WOUT), D};
        pg8::StaticOrderT<T / 256, D / 256> S; S.init(F.G, (int)blockIdx.x);
        pg8::EpiOutProj E{(const pg8::bf16_t*)(ws + WS_XB), (pg8::bf16_t*)(ws + WS_HB), (float*)(ws + WS_HST)};
        pg8::gemm_phase<pg8::EpiOutProj, pg8::StaticOrderT<T / 256, D / 256>, false>(F.lds + RING_OFF, g, S, E, F.wave);
        if (F.grp) p4_stage_weights_dma(F);
    } GSEAM(3, 16u);
    if (IN(4)) { p4_router(F, args, F.grp != 0); } SEAM(4);
    if (IN(5)) {
        moe_tables(F, PROBE_PHASE == 5 ? 2 : 1);
        pg8::Gemm g{(const pg8::bf16_t*)(ws + WS_H8), (const pg8::bf16_t*)(ws + WS_W1), D / 2};
        MoeOrder<0> S{(const LAS int*)(F.lds + L_ULIST), (const int*)(ws + WS_ELIST), (const float*)(ws + WS_EVALS), F.lds + L_ROWTAB};
        pg8::EpiMoeUp E{ws + WS_XB, F.lds + L_ROWTAB, ws + WS_DUMP + (size_t)blockIdx.x * 1024};
        pg8::gemm_phase<pg8::EpiMoeUp, MoeOrder<0>, true, true>(F.lds + RING_OFF, g, S, E, F.wave);
        { const int total = __builtin_amdgcn_readfirstlane(((const LAS int*)(F.lds + L_TSTART))[NE]) * 4, rem = total % F.G;
          if (F.vcu >= rem) conv_items<2>(args, ws, (F.vcu - rem) * NWAVES + F.wave, (F.G - rem) * NWAVES, W2_NITEMS, (LAS unsigned char*)(F.lds + RING_OFF + F.wave * 16384), olane()); }
    } SEAM(5);
    if (IN(6)) REPS(6) {
        if (!IN(5) || PROBE_PHASE == 5) moe_tables(F, 1);
        pg8::Gemm g{(const pg8::bf16_t*)(ws + WS_XB), (const pg8::bf16_t*)(ws + WS_W2), FF / 2};
        MoeOrder<1> S{(const LAS int*)(F.lds + L_ULIST), (const int*)(ws + WS_ELIST), (const float*)(ws + WS_EVALS), F.lds + L_ROWTAB};
        pg8::EpiMoeDown E{ws + WS_Y, F.lds + L_ROWTAB, (PROBE_PHASE == 6 && rep_ == 1) ? PROBE_MODE : 0};
        pg8::gemm_phase<pg8::EpiMoeDown, MoeOrder<1>, false, true>(F.lds + RING_OFF, g, S, E, F.wave);
    } SEAM(6);
    if (IN(7)) REPS(7) { p7_combine(F); }
#undef IN
#undef SEAM
}

extern "C" void kernel_launch(void* const* d_in, const int* in_sizes, int n_in, void* d_out, int out_size, void* d_ws, size_t ws_size, hipStream_t stream) {
    static int grid = 0;
    if (grid == 0) {
        if (n_in != 25 || in_sizes[0] != T * D || out_size != T * D || ws_size < WS_END) { fprintf(stderr, "kernel_launch: shape/workspace mismatch (n_in %d, in0 %d, out %d, ws %zu); nothing launched\n", n_in, n_in > 0 ? in_sizes[0] : -1, out_size, ws_size); grid = -1; return; }
        int dev = 0, cus = 0, per_cu = 0;
        if (hipGetDevice(&dev) != hipSuccess || hipDeviceGetAttribute(&cus, hipDeviceAttributeMultiprocessorCount, dev) != hipSuccess) { grid = -1; return; }
        if (hipFuncSetAttribute((const void*)hymba_fwd, hipFuncAttributeMaxDynamicSharedMemorySize, LDS_BYTES) != hipSuccess) { fprintf(stderr, "kernel_launch: hipFuncSetAttribute failed\n"); grid = -1; return; }
        if (hipOccupancyMaxActiveBlocksPerMultiprocessor(&per_cu, (const void*)hymba_fwd, NWAVES * 64, LDS_BYTES) != hipSuccess || per_cu < 1) { fprintf(stderr, "kernel_launch: occupancy query reports %d workgroups per CU\n", per_cu); }
        (void)hipGetLastError();
        grid = cus;
        if (grid > 256) grid = 256;
    }
    if (grid < 0) return;
#if PROBE_PHASE == 99
    for (int pass_ = 0; pass_ < 2; ++pass_) {
#endif
    if (hipMemsetAsync((char*)d_ws + WS_CTL, 0, CTL_ZERO_BYTES, stream) != hipSuccess) return;
    Args a{};
    for (int i = 0; i < 25; ++i) a.in[i] = (const float*)d_in[i];
    a.out = (float*)d_out; a.ws = (unsigned char*)d_ws;
    for (int i = 0; i < 8; ++i) a.ifq.f[i] = powf(500000.0f, -(float)(2 * i) / 16.0f);
    for (int li = 0; li < N_LAUNCHES; ++li) {
        a.ph_lo = (N_LAUNCHES == 1) ? 0 : li; a.ph_hi = (N_LAUNCHES == 1) ? NPH : li + 1;
        hipLaunchKernelGGL(hymba_fwd, dim3(grid), dim3(NWAVES * 64), LDS_BYTES, stream, a);
    }
#if PROBE_PHASE == 99
    }
#endif
}
```
